# Optimizing an MI355X kernel written in HIP

```python
import jax, jax.numpy as jnp
from jax import lax
import numpy as np

D_MODEL = 1024
BATCH = 8
SEQ = 2048
DEPTH = 1
DEC_BATCH = 128
DEC_SEQ = 1
PAST_LEN = 16384
PAGE_SIZE = 128

CONV_WIDTH = 3
CONV_DIM = D_MODEL
GLA_HEADS = 4
GLA_DK = (D_MODEL // 2) // GLA_HEADS
GLA_DV = D_MODEL // GLA_HEADS
GATE_RANK = 16
GATE_NORMALIZER = 16.0
GLA_CHUNK = 64
D_FF = -(-8 * D_MODEL // (3 * 256)) * 256
PLE_DIM = 256
EPS = 1e-6
SPLITS = (CONV_DIM, CONV_DIM, CONV_DIM,
          GLA_HEADS * GLA_DK, GLA_HEADS * GLA_DK,
          GLA_HEADS * GLA_DV, GLA_HEADS * GLA_DV,
          GATE_RANK, D_MODEL, D_MODEL)
N_IN_COLS = sum(SPLITS)

kernel_name = "hybrid_shortconv_gla_gated_merge_step"


def rms_norm(x, w):
    x32 = x.astype(jnp.float32)
    y = x32 * lax.rsqrt(jnp.mean(x32 * x32, axis=-1, keepdims=True) + EPS)
    return (y * w.astype(jnp.float32)).astype(x.dtype)


def gla_recurrence(q, k, v, logw, s0):
    bsz, t = q.shape[0], q.shape[1]
    c = min(GLA_CHUNK, t)
    n = -(-t // c)
    pad = n * c - t

    def prep(a):
        a = jnp.pad(a, ((0, 0), (0, pad), (0, 0), (0, 0)))
        return a.reshape(bsz, n, c, a.shape[2], a.shape[3]).transpose(1, 0, 3, 2, 4)

    qc, kc, vc, wc = prep(q), prep(k), prep(v), prep(logw)
    mask = jnp.tril(jnp.ones((c, c), dtype=bool))

    def step(s, inp):
        qi, ki, vi, wi = inp
        b = jnp.cumsum(wi, axis=2)
        inter = jnp.einsum('bhtk,bhkv->bhtv', qi * jnp.exp(b), s)
        diff = b[:, :, :, None, :] - b[:, :, None, :, :]
        decay = jnp.where(mask[:, :, None], jnp.exp(jnp.minimum(diff, 0.0)), 0.0)
        scores = jnp.einsum('bhtk,bhsk,bhtsk->bhts', qi, ki, decay)
        intra = jnp.einsum('bhts,bhsv->bhtv', scores, vi)
        b_last = b[:, :, -1, :]
        s_new = jnp.exp(b_last)[..., None] * s + jnp.einsum(
            'bhsk,bhsv->bhkv', ki * jnp.exp(b_last[:, :, None, :] - b), vi)
        return s_new, inter + intra

    s_fin, o = lax.scan(step, s0, (qc, kc, vc, wc))
    o = o.transpose(1, 0, 3, 2, 4).reshape(bsz, n * c, GLA_HEADS, GLA_DV)[:, :t]
    return o, s_fin


def trunk_layer(x, p, conv_buf, s0, w_norm_mix_pre, w_in, w_conv, w_a_out, w_gk, b_gk, w_gla_norm,
                w_b_out, w_o, w_norm_mix_post, w_norm_ffn_pre, w_ffn_gate, w_ffn_up, w_ffn_down,
                w_norm_ffn_post, w_ple_proj, w_ple_gate, w_norm_ple_post):
    bsz, t, _ = x.shape
    hn = rms_norm(x, w_norm_mix_pre)
    z = jnp.einsum('btd,dn->btn', hn, w_in)
    idx = [int(i) for i in np.cumsum(SPLITS)[:-1]]
    b_a, c_a, x_a, q, k, v, g, gk_lr, gate_a, gate_b = jnp.split(z, idx, axis=-1)

    u = c_a * x_a
    up = jnp.concatenate([conv_buf.astype(u.dtype), u], axis=1)
    y_conv = (w_conv[0] * up[:, 0:t] + w_conv[1] * up[:, 1:t + 1] + w_conv[2] * up[:, 2:t + 2])
    new_buf = up[:, t:t + CONV_WIDTH - 1]
    y_a = jnp.einsum('btc,cd->btd', b_a * y_conv, w_a_out)

    qh = q.reshape(bsz, t, GLA_HEADS, GLA_DK).astype(jnp.float32) * (GLA_DK ** -0.5)
    kh = k.reshape(bsz, t, GLA_HEADS, GLA_DK).astype(jnp.float32)
    vh = v.reshape(bsz, t, GLA_HEADS, GLA_DV).astype(jnp.float32)
    gk = (jnp.einsum('btr,rk->btk', gk_lr, w_gk) + b_gk).astype(jnp.float32)
    logw = (jax.nn.log_sigmoid(gk) / GATE_NORMALIZER).reshape(bsz, t, GLA_HEADS, GLA_DK)
    o, s_new = gla_recurrence(qh, kh, vh, logw, s0.astype(jnp.float32))
    o = o * lax.rsqrt(jnp.mean(o * o, axis=-1, keepdims=True) + EPS) * w_gla_norm.astype(jnp.float32)
    o = (o * jax.nn.silu(g.reshape(bsz, t, GLA_HEADS, GLA_DV).astype(jnp.float32))).astype(x.dtype)
    y_b = jnp.einsum('btf,fd->btd', o.reshape(bsz, t, GLA_HEADS * GLA_DV), w_b_out)

    merged = jax.nn.sigmoid(gate_a) * y_a + jax.nn.sigmoid(gate_b) * y_b
    mix = jnp.einsum('btd,de->bte', merged, w_o)
    h = x + rms_norm(mix, w_norm_mix_post)

    f = rms_norm(h, w_norm_ffn_pre)
    f = jax.nn.silu(jnp.einsum('btd,df->btf', f, w_ffn_gate)) * jnp.einsum('btd,df->btf', f, w_ffn_up)
    f = jnp.einsum('btf,fd->btd', f, w_ffn_down)
    h = h + rms_norm(f, w_norm_ffn_post)

    e = jnp.einsum('btp,pd->btd', p, w_ple_proj) * jax.nn.sigmoid(jnp.einsum('btd,de->bte', h, w_ple_gate))
    h = h + rms_norm(e, w_norm_ple_post)
    return h, new_buf, s_new


def setup_inputs(seed: int = 0) -> dict:
    key = jax.random.key(seed)
    ks = jax.random.split(key, 32)
    f32 = jnp.float32

    def nrm(k, shape, scale):
        return jax.random.normal(k, shape, f32) * scale

    def gain(k, shape):
        return 1.0 + 0.05 * jax.random.normal(k, shape, f32)

    return {
        "x_prompt": nrm(ks[0], (BATCH, SEQ, D_MODEL), 1.0),
        "x_sample": nrm(ks[1], (DEC_BATCH, DEC_SEQ, D_MODEL), 1.0),
        "state_conv": nrm(ks[2], (DEPTH, DEC_BATCH, CONV_WIDTH - 1, CONV_DIM), 1.0),
        "state_gla": nrm(ks[3], (DEPTH, DEC_BATCH, GLA_HEADS, GLA_DK, GLA_DV), 0.5),
        "p_prompt": nrm(ks[4], (DEPTH, BATCH, SEQ, PLE_DIM), 1.0),
        "p_sample": nrm(ks[5], (DEPTH, DEC_BATCH, DEC_SEQ, PLE_DIM), 1.0),
        "w_norm_mix_pre": gain(ks[6], (DEPTH, D_MODEL)),
        "w_in": nrm(ks[7], (DEPTH, D_MODEL, N_IN_COLS), D_MODEL ** -0.5),
        "w_conv": nrm(ks[8], (DEPTH, CONV_WIDTH, CONV_DIM), CONV_WIDTH ** -0.5),
        "w_a_out": nrm(ks[9], (DEPTH, CONV_DIM, D_MODEL), CONV_DIM ** -0.5),
        "w_gk": nrm(ks[10], (DEPTH, GATE_RANK, GLA_HEADS * GLA_DK), GATE_RANK ** -0.5),
        "b_gk": nrm(ks[11], (DEPTH, GLA_HEADS * GLA_DK), 0.1),
        "w_gla_norm": gain(ks[12], (DEPTH, GLA_DV)),
        "w_b_out": nrm(ks[13], (DEPTH, GLA_HEADS * GLA_DV, D_MODEL), (GLA_HEADS * GLA_DV) ** -0.5),
        "w_o": nrm(ks[14], (DEPTH, D_MODEL, D_MODEL), D_MODEL ** -0.5),
        "w_norm_mix_post": gain(ks[15], (DEPTH, D_MODEL)),
        "w_norm_ffn_pre": gain(ks[16], (DEPTH, D_MODEL)),
        "w_ffn_gate": nrm(ks[17], (DEPTH, D_MODEL, D_FF), D_MODEL ** -0.5),
        "w_ffn_up": nrm(ks[18], (DEPTH, D_MODEL, D_FF), D_MODEL ** -0.5),
        "w_ffn_down": nrm(ks[19], (DEPTH, D_FF, D_MODEL), D_FF ** -0.5),
        "w_norm_ffn_post": gain(ks[20], (DEPTH, D_MODEL)),
        "w_ple_proj": nrm(ks[21], (DEPTH, PLE_DIM, D_MODEL), PLE_DIM ** -0.5),
        "w_ple_gate": nrm(ks[22], (DEPTH, D_MODEL, D_MODEL), D_MODEL ** -0.5),
        "w_norm_ple_post": gain(ks[23], (DEPTH, D_MODEL)),
    }


def reference(x_prompt, x_sample, state_conv, state_gla, p_prompt, p_sample,
              w_norm_mix_pre, w_in, w_conv, w_a_out, w_gk, b_gk, w_gla_norm, w_b_out, w_o,
              w_norm_mix_post, w_norm_ffn_pre, w_ffn_gate, w_ffn_up, w_ffn_down, w_norm_ffn_post,
              w_ple_proj, w_ple_gate, w_norm_ple_post):
    hp, hs = x_prompt, x_sample
    conv_p, gla_p, conv_s, gla_s = [], [], [], []
    for i in range(DEPTH):
        weights = (w_norm_mix_pre[i], w_in[i], w_conv[i], w_a_out[i], w_gk[i], b_gk[i], w_gla_norm[i],
                   w_b_out[i], w_o[i], w_norm_mix_post[i], w_norm_ffn_pre[i], w_ffn_gate[i], w_ffn_up[i],
                   w_ffn_down[i], w_norm_ffn_post[i], w_ple_proj[i], w_ple_gate[i], w_norm_ple_post[i])
        buf0 = jnp.zeros((BATCH, CONV_WIDTH - 1, CONV_DIM), x_prompt.dtype)
        s0 = jnp.zeros((BATCH, GLA_HEADS, GLA_DK, GLA_DV), jnp.float32)
        hp, cbp, sp = trunk_layer(hp, p_prompt[i], buf0, s0, *weights)
        hs, cbs, ss = trunk_layer(hs, p_sample[i], state_conv[i], state_gla[i], *weights)
        conv_p.append(cbp); gla_p.append(sp); conv_s.append(cbs); gla_s.append(ss)
    new_conv_prompt = jnp.stack(conv_p)
    new_gla_prompt = jnp.stack(gla_p)
    new_conv_sample = jnp.stack(conv_s)
    new_gla_sample = jnp.stack(gla_s)
    return (hp, hs, new_conv_prompt, new_gla_prompt, new_conv_sample, new_gla_sample)
```

```cpp
#include <hip/hip_runtime.h>
#include <hip/hip_cooperative_groups.h>
#include <cstdio>
#include <cstdint>
namespace cg = cooperative_groups;
#ifndef REP_LIST
#define REP_LIST 1,1,1,1,1,1,1,1,1,1,1,1,1,1,1,1
#endif
#ifndef PHASE_LIST
#define PHASE_LIST 0,1,2,3,4,5,6,7,8,9,10,11,12
#endif
#ifndef MK_PER_PHASE
#define MK_PER_PHASE 0
#endif
namespace pg8 {
#define PG8_LAS __attribute__((address_space(3)))
typedef unsigned short bf16_t;
typedef short bf16x8 __attribute__((ext_vector_type(8)));
typedef float f32x4 __attribute__((ext_vector_type(4)));
typedef unsigned u32x4 __attribute__((ext_vector_type(4)));
constexpr int BM = 256, BK = 64, HALF = 128, HTB = HALF * BK * 2  , STAGE_BYTES = 8 * HTB, NXCD = 8, WGM = 8;

__host__ __device__ __forceinline__ int lds_byte(int r, int c) { const int st = (r >> 4) * 2 + (c >> 5), rr = r & 15, cc = c & 31, ob = rr * 64 + cc * 2; return st * 1024 + (ob ^ (((ob >> 9) & 1) << 5)); }
__host__ __device__ __forceinline__ void stage_rc(int b, int& R, int& C) { const int st = b / 1024, sb = b % 1024, swz = sb ^ (((sb >> 9) & 1) << 5); R = (st >> 1) * 16 + swz / 64; C = (st & 1) * 32 + (swz % 64) / 2; }
__host__ __device__ __forceinline__ int perm32(int rho) { const int n = rho >> 4, i = rho & 15; return 8 * (i >> 2) + 4 * n + (i & 3); }

struct Unit { int pm, pn; };
struct Gemm { const bf16_t* A; const bf16_t* Bt; int M, N, K; };

struct StaticOrder {
    int nM, nN, nwg, G, c;
    __host__ __device__ void init(int M, int N, int G_, int c_) { nM = M / BM; nN = N / BM; nwg = nM * nN; G = G_; c = c_; }
    __host__ __device__ bool next(int i, Unit& u) const {
        const long L = (long)i * G + c; if (L >= nwg) return false;
        int wgid = (int)L; { const int q = nwg / NXCD, r = nwg % NXCD, xcd = wgid % NXCD, off = wgid / NXCD; wgid = (xcd < r ? xcd * (q + 1) : r * (q + 1) + (xcd - r) * q) + off; }
        const int nig = WGM * nN, gid = wgid / nig, fm = gid * WGM, gsz = (nM - fm) < WGM ? (nM - fm) : WGM;
        u.pm = fm + ((wgid % nig) % gsz); u.pn = (wgid % nig) / gsz; return true;
    }
    __device__ __forceinline__ void a_ready(const Unit&) const {}
    __device__ __forceinline__ void done(const Unit&) const {}
};

__device__ __forceinline__ unsigned cvt_pk_bf16(float lo, float hi) { unsigned r; asm volatile("v_cvt_pk_bf16_f32 %0, %1, %2" : "=v"(r) : "v"(lo), "v"(hi)); return r; }
template <class Epi, class Sched, bool ALIGN_EPI = false, bool SP2 = false>
__device__ __forceinline__ void gemm_phase(PG8_LAS unsigned char* lds, const Gemm g, const Sched& S, const Epi& E) {
    const int tid = threadIdx.x, wid = __builtin_amdgcn_readfirstlane(tid >> 6), lane = tid & 63, wr = wid >> 2, wc = wid & 3, fr = lane & 15, fq = lane >> 4;
    const int K = g.K, nt = K / BK;
    unsigned voffA[2], voffB[2];
#pragma unroll
    for (int i = 0; i < 2; ++i) { int R, C; stage_rc(tid * 16 + i * 8192, R, C); const int Rb = Epi::PERM ? ((R & ~31) + perm32(R & 31)) : R;
        voffA[i] = (unsigned)(R * K + C) * 2u; voffB[i] = (unsigned)(Rb * K + C) * 2u; }
    const size_t kstep = (size_t)(BK * 2);
    const size_t hstep = (size_t)HALF * K * 2;
    const size_t tstep = 2 * hstep;
    const unsigned ldsw = (unsigned)wid * 1024u;
    const int aoff = lds_byte(wr * 64 + fr, fq * 8), boff = lds_byte(wc * 32 + fr, fq * 8);
#define PG8_SA(b, h) (((b) * 2 + (h)) * HTB)
#define PG8_SB(b, h) ((4 + (b) * 2 + (h)) * HTB)
#define PG8_STAGE(bufoff, gbase, voff) do { _Pragma("unroll") for (int _i = 0; _i < 2; ++_i) \
        __builtin_amdgcn_global_load_lds((const unsigned*)((const char*)(gbase) + (voff)[_i]), (PG8_LAS unsigned*)(lds + (bufoff) + ldsw + _i * 8192), 16, 0, 0); } while (0)
#define PG8_LDA(dst, b, h) do { _Pragma("unroll") for (int m = 0; m < 4; ++m) _Pragma("unroll") for (int k = 0; k < 2; ++k) dst[m][k] = *(const PG8_LAS bf16x8*)(lds + PG8_SA(b, h) + aoff + m * 2048 + k * 1024); } while (0)
#define PG8_LDB(dst, b, h) do { _Pragma("unroll") for (int n = 0; n < 2; ++n) _Pragma("unroll") for (int k = 0; k < 2; ++k) dst[n][k] = *(const PG8_LAS bf16x8*)(lds + PG8_SB(b, h) + boff + n * 2048 + k * 1024); } while (0)
#define PG8_MMA(ai, bj, At, Bt) do { __builtin_amdgcn_s_setprio(1); _Pragma("unroll") for (int m = 0; m < 4; ++m) _Pragma("unroll") for (int n = 0; n < 2; ++n) _Pragma("unroll") for (int k = 0; k < 2; ++k) \
        acc[ai][bj][m][n] = __builtin_amdgcn_mfma_f32_16x16x32_bf16(Bt[n][k], At[m][k], acc[ai][bj][m][n], 0, 0, 0); __builtin_amdgcn_s_setprio(0); } while (0)
#define PG8_WAIT_V(n) asm volatile("s_waitcnt vmcnt(" #n ")" ::: "memory")
#define PG8_WAIT_L(n) asm volatile("s_waitcnt lgkmcnt(" #n ")" ::: "memory")
#define PG8_BAR __builtin_amdgcn_s_barrier()
#define PG8_SCHED __builtin_amdgcn_sched_barrier(0)
    Unit cur, nxt; int ui = 0;
    if (!S.next(0, cur)) return;
    f32x4 acc[2][2][4][2];
#pragma unroll
    for (int a = 0; a < 2; ++a)
#pragma unroll
        for (int b = 0; b < 2; ++b)
#pragma unroll
            for (int m = 0; m < 4; ++m)
#pragma unroll
                for (int n = 0; n < 2; ++n) acc[a][b][m][n] = (f32x4){0.f, 0.f, 0.f, 0.f};
    bf16x8 At[4][2], B0[2][2], B1[2][2];
    const char* cA = (const char*)g.A + (size_t)cur.pm * tstep; const char* cB = (const char*)g.Bt + (size_t)cur.pn * tstep;
    S.a_ready(cur);
    if constexpr (SP2) {
        PG8_STAGE(PG8_SB(0, 0), cB, voffB); PG8_STAGE(PG8_SB(0, 1), cB + hstep, voffB); PG8_STAGE(PG8_SA(0, 0), cA, voffA); PG8_STAGE(PG8_SA(0, 1), cA + hstep, voffA);
        if (wr == 1) PG8_BAR;
        PG8_WAIT_V(2); PG8_BAR;
        PG8_STAGE(PG8_SB(1, 0), cB + kstep, voffB); PG8_STAGE(PG8_SA(1, 0), cA + kstep, voffA); PG8_STAGE(PG8_SB(1, 1), cB + hstep + kstep, voffB);
        PG8_WAIT_V(6); PG8_BAR;
    } else {
        PG8_STAGE(PG8_SB(0, 0), cB, voffB); PG8_STAGE(PG8_SA(0, 0), cA, voffA); PG8_STAGE(PG8_SB(0, 1), cB + hstep, voffB); PG8_STAGE(PG8_SA(0, 1), cA + hstep, voffA);
        if (wr == 1) PG8_BAR;
        PG8_WAIT_V(4); PG8_BAR;
        PG8_STAGE(PG8_SB(1, 0), cB + kstep, voffB); PG8_STAGE(PG8_SA(1, 0), cA + kstep, voffA); PG8_STAGE(PG8_SB(1, 1), cB + hstep + kstep, voffB);
        PG8_WAIT_V(6); PG8_BAR;
    }
    for (;;) {
        const bool has_next = S.next(ui + 1, nxt);
        const char* nA = has_next ? (const char*)g.A + (size_t)nxt.pm * tstep : cA; const char* nB = has_next ? (const char*)g.Bt + (size_t)nxt.pn * tstep : cB;
        for (int t = 0; t < nt; t += 2) {
            const bool last = (t == nt - 2);
            const char* a1 = cA + (size_t)(t + 1) * kstep;
            const char* a2 = last ? nA : cA + (size_t)(t + 2) * kstep; const char* b2 = last ? nB : cB + (size_t)(t + 2) * kstep;
            const char* a3 = a2 + kstep; const char* b3 = b2 + kstep;
            if (last && has_next) S.a_ready(nxt);
            if constexpr (SP2) {
            PG8_LDB(B0, 0, 0); PG8_LDB(B1, 0, 1); PG8_SCHED; PG8_LDA(At, 0, 0); PG8_STAGE(PG8_SA(1, 1), a1 + hstep, voffA);
            PG8_WAIT_V(8); PG8_WAIT_L(0); PG8_BAR; PG8_MMA(0, 0, At, B0); PG8_MMA(0, 1, At, B1); PG8_BAR; PG8_SCHED;
            PG8_LDA(At, 0, 1); PG8_STAGE(PG8_SB(0, 0), b2, voffB); PG8_STAGE(PG8_SB(0, 1), b2 + hstep, voffB); PG8_STAGE(PG8_SA(0, 0), a2, voffA);
            PG8_WAIT_V(8); PG8_WAIT_L(0); PG8_BAR; PG8_MMA(1, 0, At, B0); PG8_MMA(1, 1, At, B1); PG8_BAR; PG8_SCHED;
            PG8_LDB(B0, 1, 0); PG8_LDB(B1, 1, 1); PG8_SCHED; PG8_LDA(At, 1, 0); PG8_STAGE(PG8_SA(0, 1), a2 + hstep, voffA);
            PG8_WAIT_V(8); PG8_WAIT_L(0); PG8_BAR; PG8_MMA(0, 0, At, B0); PG8_MMA(0, 1, At, B1); PG8_BAR; PG8_SCHED;
            PG8_LDA(At, 1, 1); PG8_STAGE(PG8_SB(1, 0), b3, voffB); PG8_STAGE(PG8_SB(1, 1), b3 + hstep, voffB); PG8_STAGE(PG8_SA(1, 0), a3, voffA);
            PG8_WAIT_V(8); PG8_WAIT_L(0); PG8_BAR; PG8_MMA(1, 0, At, B0); PG8_MMA(1, 1, At, B1); PG8_BAR; PG8_SCHED;
            } else {
            PG8_LDB(B0, 0, 0); PG8_SCHED; PG8_LDA(At, 0, 0); PG8_STAGE(PG8_SA(1, 1), a1 + hstep, voffA);
            PG8_WAIT_L(8); PG8_BAR; PG8_WAIT_L(0); PG8_MMA(0, 0, At, B0); PG8_BAR; PG8_SCHED;
            PG8_LDB(B1, 0, 1); PG8_STAGE(PG8_SB(0, 0), b2, voffB);
            PG8_BAR; PG8_WAIT_L(0); PG8_MMA(0, 1, At, B1); PG8_BAR;
            PG8_LDA(At, 0, 1); PG8_STAGE(PG8_SA(0, 0), a2, voffA);
            PG8_BAR; PG8_WAIT_L(0); PG8_MMA(1, 0, At, B0); PG8_BAR; PG8_SCHED;
            PG8_STAGE(PG8_SB(0, 1), b2 + hstep, voffB);
            PG8_WAIT_V(6); PG8_BAR; PG8_MMA(1, 1, At, B1); PG8_BAR;
            PG8_LDB(B0, 1, 0); PG8_SCHED; PG8_LDA(At, 1, 0); PG8_STAGE(PG8_SA(0, 1), a2 + hstep, voffA);
            PG8_WAIT_L(8); PG8_BAR; PG8_WAIT_L(0); PG8_MMA(0, 0, At, B0); PG8_BAR; PG8_SCHED;
            PG8_LDB(B1, 1, 1); PG8_STAGE(PG8_SB(1, 0), b3, voffB);
            PG8_BAR; PG8_WAIT_L(0); PG8_MMA(0, 1, At, B1); PG8_BAR;
            PG8_LDA(At, 1, 1); PG8_STAGE(PG8_SA(1, 0), a3, voffA);
            PG8_BAR; PG8_WAIT_L(0); PG8_MMA(1, 0, At, B0); PG8_BAR; PG8_SCHED;
            PG8_STAGE(PG8_SB(1, 1), b3 + hstep, voffB);
            PG8_WAIT_V(6); PG8_BAR; PG8_MMA(1, 1, At, B1); PG8_BAR;
            }
        }
        if constexpr (ALIGN_EPI) { if (wr == 0) PG8_BAR; }
        if constexpr (!Epi::AFTER_DRAIN) { E(acc, cur, wr, wc, fr, fq); S.done(cur); }
        if (!has_next) break;
#pragma unroll
        for (int a = 0; a < 2; ++a)
#pragma unroll
            for (int b = 0; b < 2; ++b)
#pragma unroll
                for (int m = 0; m < 4; ++m)
#pragma unroll
                    for (int n = 0; n < 2; ++n) acc[a][b][m][n] = (f32x4){0.f, 0.f, 0.f, 0.f};
        cur = nxt; cA = nA; cB = nB; ++ui;
        if constexpr (ALIGN_EPI) { if (wr == 1) PG8_BAR; }
    }
    PG8_WAIT_V(0);
    if constexpr (!ALIGN_EPI) { if (wr == 0) PG8_BAR; }
    PG8_BAR;
    if constexpr (Epi::AFTER_DRAIN) { E.fused(acc, cur, wr, wc, fr, fq, lds, wid, lane); S.done(cur); }
#undef PG8_SA
#undef PG8_SB
#undef PG8_STAGE
#undef PG8_LDA
#undef PG8_LDB
#undef PG8_MMA
#undef PG8_WAIT_V
#undef PG8_WAIT_L
#undef PG8_BAR
#undef PG8_SCHED
}
}

#define LAS __attribute__((address_space(3)))
typedef unsigned short bf16;
typedef pg8::bf16x8 bf16x8;
typedef pg8::f32x4 f32x4;
typedef pg8::u32x4 u32x4;
typedef unsigned u32x2 __attribute__((ext_vector_type(2)));

constexpr int D = 1024, TSEQ = 2048, MPROMPT = 16384, NSAMP = 128, MTOK = MPROMPT + NSAMP, MP = 16640;
constexpr int NZ = 8192, ZB = 0, ZC = 1024, ZX = 2048, ZQ = 3072, ZK = 3584, ZV = 4096, ZG = 5120, ZGA = 6144, ZGB = 7168;
constexpr int FF = 2816, PLE = 256, NWIN = 8208, GKCOL = 6144;
constexpr float EPS = 1e-6f;
constexpr size_t MiB = 1u << 20;
constexpr size_t WS_WIN = 0, WS_WA = 16 * MiB, WS_WB = 18 * MiB, WS_WO = 20 * MiB, WS_WPG = 22 * MiB, WS_WPP = 24 * MiB, WS_WGU = 25 * MiB, WS_WD = 36 * MiB;
constexpr size_t WS_GKLR = 42 * MiB, WS_PART = 44 * MiB, WS_DBUF = 46 * MiB, WS_SC = 47 * MiB, WS_KHT = 55 * MiB, WS_PB = 71 * MiB;
constexpr size_t WS_X1 = 80 * MiB, WS_X2 = 113 * MiB, WS_X3 = 146 * MiB, WS_X4 = 179 * MiB, WS_Z = 212 * MiB, WS_HID = WS_Z, WS_H = WS_Z + 96 * MiB, WS_H2 = WS_Z + 164 * MiB, WS_QT = 472 * MiB, WS_END = 488 * MiB;
constexpr size_t OUT_Y = 0, OUT_CONVP = (size_t)MTOK * D, OUT_GLAP = OUT_CONVP + 8 * 2 * 1024, OUT_CONVS = OUT_GLAP + (size_t)8 * 4 * 128 * 256, OUT_GLAS = OUT_CONVS + (size_t)128 * 2 * 1024;
constexpr int LDS_BYTES = 131072 + 256, LDS_BARST = 131072;
constexpr size_t WS_CTL = 45 * MiB + 256 * 1024, CTL_BYTES = 16384;

struct Args { const float* in[24]; float* out; unsigned char* ws; int ph_lo, ph_hi; };
constexpr int REP[16] = {REP_LIST};

struct Ctx {
    const float *xp, *xs, *st_conv, *st_gla, *pp, *ps, *w_pre, *w_in, *w_conv, *w_a, *w_gk, *b_gk, *w_gn, *w_b, *w_o, *w_post, *w_fpre, *w_fg, *w_fu, *w_fd, *w_fpost, *w_pp, *w_pg, *w_ppost;
    float* out;
    bf16 *WIN, *WA, *WB, *WO, *WPG, *WPP, *WGU, *WD, *PB, *X1, *X2, *X3, *X4, *Z, *HID, *KHT, *SC;
    float *GKLR, *PART, *DBUF; bf16 *QT, *WGK, *HB;
};

__device__ __forceinline__ float wave_sum(float v) {
#pragma unroll
    for (int o = 1; o < 64; o <<= 1) v += __shfl_xor(v, o);
    return v;
}
typedef float f32x2_t __attribute__((ext_vector_type(2))); typedef __bf16 bf16x2_t __attribute__((ext_vector_type(2)));
__device__ __forceinline__ unsigned pk2(float lo, float hi) { f32x2_t v = {lo, hi}; bf16x2_t b = __builtin_convertvector(v, bf16x2_t); return __builtin_bit_cast(unsigned, b); }
__device__ __forceinline__ float bf_lo(unsigned w) { return __uint_as_float(w << 16); }
__device__ __forceinline__ float bf_hi(unsigned w) { return __uint_as_float(w & 0xffff0000u); }
__device__ __forceinline__ float bf2f(bf16 b) { return __uint_as_float(((unsigned)b) << 16); }
__device__ __forceinline__ bf16 f2bf(float f) { return (bf16)(pk2(f, 0.f) & 0xffffu); }
__device__ __forceinline__ float sigm(float x) { return __builtin_amdgcn_rcpf(1.0f + __expf(-x)); }
__device__ __forceinline__ float siluf(float x) { return x * sigm(x); }
__device__ __forceinline__ float logsig(float g) { return fminf(g, 0.f) - __logf(1.0f + __expf(-fabsf(g))); }
__device__ __forceinline__ void unpack8(const u32x4 w, float (&v)[8]) {
    v[0] = bf_lo(w.x); v[1] = bf_hi(w.x); v[2] = bf_lo(w.y); v[3] = bf_hi(w.y); v[4] = bf_lo(w.z); v[5] = bf_hi(w.z); v[6] = bf_lo(w.w); v[7] = bf_hi(w.w);
}
__device__ __forceinline__ u32x4 pack8(const float (&v)[8]) { u32x4 w; w.x = pk2(v[0], v[1]); w.y = pk2(v[2], v[3]); w.z = pk2(v[4], v[5]); w.w = pk2(v[6], v[7]); return w; }

struct EpiStore {
    static constexpr bool PERM = true, AFTER_DRAIN = false;
    bf16* O; int ldc;
    __device__ __forceinline__ void operator()(const f32x4 (&acc)[2][2][4][2], const pg8::Unit& u, int wr, int wc, int fr, int fq) const {
        const int row0 = u.pm * 256 + wr * 64 + fr, col0 = u.pn * 256 + wc * 32 + 8 * fq;
#pragma unroll
        for (int ai = 0; ai < 2; ++ai)
#pragma unroll
            for (int m = 0; m < 4; ++m) { bf16* rowp = O + (size_t)(row0 + ai * 128 + m * 16) * ldc + col0;
#pragma unroll
                for (int bj = 0; bj < 2; ++bj) { const f32x4 v0 = acc[ai][bj][m][0], v1 = acc[ai][bj][m][1];
                    u32x4 w; w.x = pk2(v0[0], v0[1]); w.y = pk2(v0[2], v0[3]); w.z = pk2(v1[0], v1[1]); w.w = pk2(v1[2], v1[3]);
                    *(u32x4*)(rowp + bj * 128) = w; } }
    }
};
template <bool HAS_ADD> struct EpiGate {
    static constexpr bool PERM = true, AFTER_DRAIN = false;
    const bf16* zg; const bf16* add; bf16* O;
    __device__ __forceinline__ void operator()(const f32x4 (&acc)[2][2][4][2], const pg8::Unit& u, int wr, int wc, int fr, int fq) const {
        const int row0 = u.pm * 256 + wr * 64 + fr, col0 = u.pn * 256 + wc * 32 + 8 * fq;
#pragma unroll
        for (int ai = 0; ai < 2; ++ai)
#pragma unroll
            for (int m = 0; m < 4; ++m) { const size_t row = (size_t)(row0 + ai * 128 + m * 16);
#pragma unroll
                for (int bj = 0; bj < 2; ++bj) { const int col = col0 + bj * 128;
                    float g[8]; unpack8(__builtin_nontemporal_load((const u32x4*)(zg + row * NZ + col)), g);
                    const f32x4 v0 = acc[ai][bj][m][0], v1 = acc[ai][bj][m][1];
                    float o[8] = {v0[0], v0[1], v0[2], v0[3], v1[0], v1[1], v1[2], v1[3]};
#pragma unroll
                    for (int e = 0; e < 8; ++e) o[e] *= sigm(g[e]);
                    if (HAS_ADD) { float ad[8]; unpack8(__builtin_nontemporal_load((const u32x4*)(add + row * D + col)), ad);
#pragma unroll
                        for (int e = 0; e < 8; ++e) o[e] += ad[e]; }
                    *(u32x4*)(O + row * D + col) = pack8(o); } }
    }
};
template <bool MULSIG> struct EpiSq {
    static constexpr bool PERM = true, AFTER_DRAIN = false;
    bf16* O; const bf16* mul; float* part;
    __device__ __forceinline__ void operator()(const f32x4 (&acc)[2][2][4][2], const pg8::Unit& u, int wr, int wc, int fr, int fq) const {
        const int row0 = u.pm * 256 + wr * 64 + fr, col0 = u.pn * 256 + wc * 32 + 8 * fq;
#pragma unroll
        for (int ai = 0; ai < 2; ++ai)
#pragma unroll
            for (int m = 0; m < 4; ++m) { const size_t row = (size_t)(row0 + ai * 128 + m * 16); float s = 0.f;
#pragma unroll
                for (int bj = 0; bj < 2; ++bj) { const int col = col0 + bj * 128;
                    const f32x4 v0 = acc[ai][bj][m][0], v1 = acc[ai][bj][m][1];
                    float o[8] = {v0[0], v0[1], v0[2], v0[3], v1[0], v1[1], v1[2], v1[3]};
                    if (MULSIG) { float p[8]; unpack8(__builtin_nontemporal_load((const u32x4*)(mul + row * D + col)), p);
#pragma unroll
                        for (int e = 0; e < 8; ++e) o[e] = p[e] * sigm(o[e]); }
#pragma unroll
                    for (int e = 0; e < 8; ++e) s += o[e] * o[e];
                    *(u32x4*)(O + row * D + col) = pack8(o); }
                s += __shfl_xor(s, 16); s += __shfl_xor(s, 32);
                if (fq == 0) part[(size_t)(u.pn * 4 + wc) * MP + row] = s; }
    }
};
struct EpiSwiGLU {
    static constexpr bool PERM = true, AFTER_DRAIN = false;
    bf16* Hd;
    __device__ __forceinline__ void operator()(const f32x4 (&acc)[2][2][4][2], const pg8::Unit& u, int wr, int wc, int fr, int fq) const {
        const int row0 = u.pm * 256 + wr * 64 + fr, col0 = u.pn * 128 + wc * 32 + 8 * fq;
#pragma unroll
        for (int ai = 0; ai < 2; ++ai)
#pragma unroll
            for (int m = 0; m < 4; ++m) { const size_t row = (size_t)(row0 + ai * 128 + m * 16);
                const f32x4 g0 = acc[ai][0][m][0], g1 = acc[ai][0][m][1], u0 = acc[ai][1][m][0], u1 = acc[ai][1][m][1];
                float o[8];
#pragma unroll
                for (int e = 0; e < 4; ++e) { o[e] = siluf(g0[e]) * u0[e]; o[4 + e] = siluf(g1[e]) * u1[e]; }
                *(u32x4*)(Hd + row * FF + col0) = pack8(o); }
    }
};


constexpr size_t WS_WGK = 45 * MiB + 768 * 1024;
constexpr size_t WS_PARTS = 45 * MiB + 512 * 1024;
template <bool TWO, int NRB = 8, class F>
__device__ __forceinline__ void mini_gemm(const bf16* A, int row0, int n_rb, const bf16* Bt, int K, int ncu, int rot, const F& epi, LAS unsigned char* lds, int tid) {
    const int wave = tid >> 6, lane = tid & 63, l15 = lane & 15, quad = lane >> 4, G = gridDim.x;
    const int nsw = K >> 8;
    constexpr int NSUB = 8 / NRB;
    LAS f32x4* red = (LAS f32x4*)lds;
    for (int u = (int)((blockIdx.x + rot) % G); u < n_rb * NSUB * ncu; u += G) {
        const int cu = u % ncu, t_ = u / ncu, rowb = row0 + (t_ / NSUB) * 128 + (t_ % NSUB) * (16 * NRB);
        const bf16* ap = A + (size_t)(rowb + l15) * K + wave * (K >> 3) + quad * 8;
        const int brow = TWO ? ((16 * cu) >> 7) * 256 + ((16 * cu) & 127) : 16 * cu;
        const bf16* bp = Bt + (size_t)(brow + l15) * K + wave * (K >> 3) + quad * 8;
        f32x4 acc0[NRB], acc1[NRB];
#pragma unroll
        for (int r = 0; r < NRB; ++r) { acc0[r] = (f32x4){0.f, 0.f, 0.f, 0.f}; acc1[r] = (f32x4){0.f, 0.f, 0.f, 0.f}; }
        constexpr int KS = TWO ? 2 : (NRB == 8 ? 4 : 12);
        for (int s0 = 0; s0 < nsw; s0 += KS) {
            bf16x8 a[KS][NRB], b[KS], c[KS];
#pragma unroll
            for (int s = 0; s < KS; ++s) { const bool on = s0 + s < nsw; const int ko = (s0 + s) * 32;
                b[s] = on ? *(const bf16x8*)(bp + ko) : (bf16x8){0, 0, 0, 0, 0, 0, 0, 0}; if (TWO) c[s] = on ? *(const bf16x8*)(bp + (size_t)128 * K + ko) : (bf16x8){0, 0, 0, 0, 0, 0, 0, 0};
#pragma unroll
                for (int r = 0; r < NRB; ++r) a[s][r] = on ? *(const bf16x8*)(ap + (size_t)(16 * r) * K + ko) : (bf16x8){0, 0, 0, 0, 0, 0, 0, 0}; }
#pragma unroll
            for (int s = 0; s < KS; ++s)
#pragma unroll
                for (int r = 0; r < NRB; ++r) { acc0[r] = __builtin_amdgcn_mfma_f32_16x16x32_bf16(b[s], a[s][r], acc0[r], 0, 0, 0); if (TWO) acc1[r] = __builtin_amdgcn_mfma_f32_16x16x32_bf16(c[s], a[s][r], acc1[r], 0, 0, 0); }
        }
        f32x4 t0 = (f32x4){0.f, 0.f, 0.f, 0.f}, t1 = (f32x4){0.f, 0.f, 0.f, 0.f};
#pragma unroll
        for (int r = 0; r < NRB; ++r) red[(wave * NRB + r) * 64 + lane] = acc0[r];
        __syncthreads();
        if (wave < NRB) {
#pragma unroll
            for (int s = 0; s < 8; ++s) t0 += red[(s * NRB + wave) * 64 + lane]; }
        __syncthreads();
        if (TWO) {
#pragma unroll
            for (int r = 0; r < NRB; ++r) red[(wave * NRB + r) * 64 + lane] = acc1[r];
            __syncthreads();
            if (wave < NRB) {
#pragma unroll
                for (int s = 0; s < 8; ++s) t1 += red[(s * NRB + wave) * 64 + lane]; }
            __syncthreads();
        }
        if (wave < NRB) epi(cu, rowb + 16 * wave + l15, 16 * cu + 4 * quad, t0, t1);
    }
}
struct MiniF32 { float* O; int ldc; __device__ __forceinline__ void operator()(int, int row, int col, const f32x4 v, const f32x4) const { *(f32x4*)(O + (size_t)row * ldc + col) = v; } };
__device__ __forceinline__ void st4(bf16* p, const f32x4 v) { *(u32x2*)p = (u32x2){pk2(v[0], v[1]), pk2(v[2], v[3])}; }
__device__ __forceinline__ f32x4 ld4(const bf16* p) { const u32x2 w = *(const u32x2*)p; return (f32x4){bf_lo(w.x), bf_hi(w.x), bf_lo(w.y), bf_hi(w.y)}; }
__device__ __forceinline__ f32x4 sig4(const f32x4 g) { return (f32x4){sigm(g[0]), sigm(g[1]), sigm(g[2]), sigm(g[3])}; }
struct MiniStore { bf16* O; int ldc; __device__ __forceinline__ void operator()(int, int row, int col, const f32x4 v, const f32x4) const { st4(O + (size_t)row * ldc + col, v); } };
template <bool HAS_ADD> struct MiniGate { const bf16* zg; const bf16* add; bf16* O;
    __device__ __forceinline__ void operator()(int, int row, int col, const f32x4 v, const f32x4) const { f32x4 o = sig4(ld4(zg + (size_t)row * NZ + col)) * v; if (HAS_ADD) o += ld4(add + (size_t)row * D + col); st4(O + (size_t)row * D + col, o); } };
template <bool MULSIG> struct MiniSq { bf16* O; const bf16* mul; float* parts;
    __device__ __forceinline__ void operator()(int u, int row, int col, const f32x4 v, const f32x4) const { f32x4 o = v; if (MULSIG) o = ld4(mul + (size_t)row * D + col) * sig4(v);
        st4(O + (size_t)row * D + col, o); float s = (o[0] * o[0] + o[1] * o[1]) + (o[2] * o[2] + o[3] * o[3]); s += __shfl_xor(s, 16); s += __shfl_xor(s, 32);
        if ((threadIdx.x & 63) < 16) parts[(size_t)u * NSAMP + (row - MPROMPT)] = s; } };
struct MiniSwiGLU { bf16* Hd; __device__ __forceinline__ void operator()(int, int row, int col, const f32x4 g, const f32x4 up) const { st4(Hd + (size_t)row * FF + col, (f32x4){siluf(g[0]) * up[0], siluf(g[1]) * up[1], siluf(g[2]) * up[2], siluf(g[3]) * up[3]}); } };

template <bool WT_NT = true>
__device__ __forceinline__ void p0_transpose_item(const float* W, int ldn, int k0, int nsrc0, bf16* WT, int K, int drow0, LAS float* scr, int lane) {
    float tv[32];
#pragma unroll
    for (int i = 0; i < 32; ++i) tv[i] = __builtin_nontemporal_load(W + (size_t)(k0 + 2 * i + (lane >> 5)) * ldn + nsrc0 + (lane & 31));
#pragma unroll
    for (int i = 0; i < 32; ++i) scr[(2 * i + (lane >> 5)) * 33 + (lane & 31)] = tv[i];
    asm volatile("s_waitcnt lgkmcnt(0)" ::: "memory");
    const int c = lane & 7;
#pragma unroll
    for (int j = 0; j < 4; ++j) { const int n = (lane >> 3) + 8 * j; const LAS float* s = scr + (8 * c) * 33 + n;
        u32x4 o; o.x = pk2(s[0 * 33], s[1 * 33]); o.y = pk2(s[2 * 33], s[3 * 33]); o.z = pk2(s[4 * 33], s[5 * 33]); o.w = pk2(s[6 * 33], s[7 * 33]);
        if (WT_NT) __builtin_nontemporal_store(o, (u32x4*)(WT + (size_t)(drow0 + n) * K + k0 + 8 * c)); else *(u32x4*)(WT + (size_t)(drow0 + n) * K + k0 + 8 * c) = o; }
    asm volatile("s_waitcnt lgkmcnt(0)" ::: "memory");
}
__device__ __forceinline__ void p0_items(const Ctx& C, LAS unsigned char* lds, int tid, bool late) {
    const int wave = tid >> 6, lane = tid & 63, gw = blockIdx.x * 8 + wave, NGW = gridDim.x * 8;
    LAS float* scr = (LAS float*)(lds + wave * 8704);
    constexpr int I_IN = 16 * 256, I_SQ = 16 * 32, I_PP = 4 * 32, I_GU = 16 * 176, I_FD = 44 * 32;
    constexpr int NITEMS = I_IN + 4 * I_SQ + I_PP + I_GU + I_FD;
    const int lo = late ? I_IN : 0, hi = late ? NITEMS : I_IN;
    for (int it = lo + gw; it < hi; it += NGW) {
        int r = it;
        if (r < I_IN) { const int kb = r >> 8, nb = r & 255; p0_transpose_item<false>(C.w_in, NWIN, 64 * kb, 32 * nb + (32 * nb >= GKCOL ? 16 : 0), C.WIN, D, 32 * nb, scr, lane); continue; } r -= I_IN;
        if (r < 4 * I_SQ) { const int w = r / I_SQ, q = r % I_SQ, kb = q >> 5, nb = q & 31; const float* src = w == 0 ? C.w_a : w == 1 ? C.w_b : w == 2 ? C.w_o : C.w_pg; bf16* dst = w == 0 ? C.WA : w == 1 ? C.WB : w == 2 ? C.WO : C.WPG;
            p0_transpose_item(src, D, 64 * kb, 32 * nb, dst, D, 32 * nb, scr, lane); continue; } r -= 4 * I_SQ;
        if (r < I_PP) { const int kb = r >> 5, nb = r & 31; p0_transpose_item(C.w_pp, D, 64 * kb, 32 * nb, C.WPP, PLE, 32 * nb, scr, lane); continue; } r -= I_PP;
        if (r < I_GU) { const int kb = r / 176, nb = r % 176, tile = nb >> 3, w = nb & 7; p0_transpose_item(w < 4 ? C.w_fg : C.w_fu, FF, 64 * kb, 128 * tile + 32 * (w & 3), C.WGU, D, 32 * nb, scr, lane); continue; } r -= I_GU;
        { const int kb = r >> 5, nb = r & 31; p0_transpose_item(C.w_fd, D, 64 * kb, 32 * nb, C.WD, FF, 32 * nb, scr, lane); }
    }
}
__device__ __forceinline__ void p0_late(const Ctx& C, LAS unsigned char* lds, int tid) {
    p0_items(C, lds, tid, true);
    for (int idx = blockIdx.x * 512 + tid; idx < MP * 32; idx += gridDim.x * 512) {
        const int row = idx >> 5, c8 = (idx & 31) * 8; u32x4 o = (u32x4){0u, 0u, 0u, 0u};
        if (row < MTOK) { const float* src = row < MPROMPT ? C.pp + (size_t)row * PLE + c8 : C.ps + (size_t)(row - MPROMPT) * PLE + c8;
            const f32x4 a = __builtin_nontemporal_load((const f32x4*)src), b = __builtin_nontemporal_load((const f32x4*)(src + 4)); o.x = pk2(a[0], a[1]); o.y = pk2(a[2], a[3]); o.z = pk2(b[0], b[1]); o.w = pk2(b[2], b[3]); }
        __builtin_nontemporal_store(o, (u32x4*)(C.PB + (size_t)row * PLE + c8));
    }
}
__device__ __forceinline__ void p0_prologue(const Ctx& C, LAS unsigned char* lds, int tid) {
    const int wave = tid >> 6, lane = tid & 63, gw = blockIdx.x * 8 + wave, NGW = gridDim.x * 8;
    p0_items(C, lds, tid, false);
    for (int idx = blockIdx.x * 512 + tid; idx < D * 16; idx += gridDim.x * 512) { const int c = idx >> 4, r = idx & 15; C.WGK[r * D + c] = f2bf(C.w_in[(size_t)c * NWIN + GKCOL + r]); }
    f32x4 wp[4];
#pragma unroll
    for (int j = 0; j < 4; ++j) wp[j] = *(const f32x4*)(C.w_pre + 4 * lane + 256 * j);
    for (int m0 = gw; m0 < MTOK; m0 += 4 * NGW) {
        f32x4 v[4][4];
#pragma unroll
        for (int r = 0; r < 4; ++r) { const int m = m0 + r * NGW;
#pragma unroll
            for (int j = 0; j < 4; ++j) { v[r][j] = (f32x4){0.f, 0.f, 0.f, 0.f};
                if (m < MTOK) v[r][j] = __builtin_nontemporal_load((const f32x4*)(m < MPROMPT ? C.xp + (size_t)m * D + 4 * lane + 256 * j : C.xs + (size_t)(m - MPROMPT) * D + 4 * lane + 256 * j)); } }
#pragma unroll
        for (int r = 0; r < 4; ++r) { const int m = m0 + r * NGW; if (m >= MTOK) continue;
            float s = 0.f;
#pragma unroll
            for (int j = 0; j < 4; ++j) s += (v[r][j][0] * v[r][j][0] + v[r][j][1] * v[r][j][1]) + (v[r][j][2] * v[r][j][2] + v[r][j][3] * v[r][j][3]);
            const float rstd = 1.0f / sqrtf(wave_sum(s) * (1.0f / D) + EPS);
#pragma unroll
            for (int j = 0; j < 4; ++j) { const f32x4 o = v[r][j] * rstd * wp[j]; *(u32x2*)(C.X1 + (size_t)m * D + 4 * lane + 256 * j) = (u32x2){pk2(o[0], o[1]), pk2(o[2], o[3])}; } }
    }
}

__device__ __forceinline__ void gla_prep_item(const Ctx& C, int item, LAS unsigned char* lds, int tid) {
    const int b = item >> 7, h = (item >> 5) & 3, n = item & 31, row0 = b * TSEQ + n * 64;
    LAS float* gkl = (LAS float*)lds;
    LAS float* csum = (LAS float*)(lds + 4096);
    LAS bf16* Qs = (LAS bf16*)(lds + 8192);
    LAS bf16* Ks = (LAS bf16*)(lds + 8192 + 17408);
    const int col = tid & 127, rg = tid >> 7;
    if (tid < 256) ((LAS f32x4*)gkl)[tid] = ((const f32x4*)(C.GKLR + (size_t)row0 * 16))[tid];
    float wg[16];
#pragma unroll
    for (int r = 0; r < 16; ++r) wg[r] = C.w_gk[r * 512 + h * 128 + col];
    const float bias = C.b_gk[h * 128 + col];
    __syncthreads();
    float bl[16]; float c = 0.f;
#pragma unroll
    for (int i = 0; i < 16; ++i) { const int row = rg * 16 + i; float g = bias;
#pragma unroll
        for (int r = 0; r < 16; ++r) g += gkl[row * 16 + r] * wg[r];
        c += logsig(g) * (1.0f / 16.0f); bl[i] = c; }
    csum[rg * 128 + col] = c;
    __syncthreads();
    const float c0 = csum[col], c1 = csum[128 + col], c2 = csum[256 + col], c3 = csum[384 + col];
    const float off = rg == 0 ? 0.f : rg == 1 ? c0 : rg == 2 ? c0 + c1 : c0 + c1 + c2;
    const float bm = c0 + c1, blast = bm + c2 + c3;
    const bf16* zq = C.Z + (size_t)(row0 + rg * 16) * NZ + ZQ + h * 128 + col;
    bf16* qt = C.QT + (size_t)(row0 + rg * 16) * 512 + h * 128 + col;
    const bf16* zk = C.Z + (size_t)(row0 + rg * 16) * NZ + ZK + h * 128 + col;
    const float scale = 0.08838834764831845f;
    unsigned khp[8];
#pragma unroll
    for (int i = 0; i < 16; i += 2) {
        float kh2[2];
#pragma unroll
        for (int e = 0; e < 2; ++e) { const int ii = i + e; const float bb = bl[ii] + off; const float q = bf2f(__builtin_nontemporal_load(zq + (size_t)ii * NZ)) * scale, k = bf2f(__builtin_nontemporal_load(zk + (size_t)ii * NZ));
            qt[(size_t)ii * 512] = f2bf(q * __expf(bb));
            Qs[(rg * 16 + ii) * 136 + col] = f2bf(q * __expf(bb - bm)); Ks[(rg * 16 + ii) * 136 + col] = f2bf(k * __expf(bm - bb));
            kh2[e] = k * __expf(blast - bb); }
        khp[i >> 1] = pk2(kh2[0], kh2[1]);
    }
    { bf16* dst = C.KHT + ((size_t)item * 128 + col) * 64 + rg * 16;
      *(u32x4*)dst = (u32x4){khp[0], khp[1], khp[2], khp[3]}; *(u32x4*)(dst + 8) = (u32x4){khp[4], khp[5], khp[6], khp[7]}; }
    if (rg == 0) C.DBUF[(size_t)item * 128 + col] = __expf(blast);
    __syncthreads();
    const int wave = tid >> 6, lane = tid & 63, l15 = lane & 15, quad = lane >> 4, tr = wave >> 1;
#pragma unroll
    for (int cc = 0; cc < 2; ++cc) { const int tc = (wave & 1) * 2 + cc; u32x2 ow = (u32x2){0u, 0u};
        const int t = tr * 16 + l15, s0 = tc * 16 + quad * 4;
        if (tc <= tr) { f32x4 acc = (f32x4){0.f, 0.f, 0.f, 0.f};
#pragma unroll
            for (int kk = 0; kk < 4; ++kk) { const bf16x8 a = *(const LAS bf16x8*)(Ks + (tc * 16 + l15) * 136 + kk * 32 + quad * 8), bq = *(const LAS bf16x8*)(Qs + (tr * 16 + l15) * 136 + kk * 32 + quad * 8);
                acc = __builtin_amdgcn_mfma_f32_16x16x32_bf16(a, bq, acc, 0, 0, 0); }
#pragma unroll
            for (int j = 0; j < 4; ++j) if (s0 + j > t) acc[j] = 0.f;
            ow.x = pk2(acc[0], acc[1]); ow.y = pk2(acc[2], acc[3]); }
        *(u32x2*)(C.SC + ((size_t)item * 64 + t) * 64 + s0) = ow; }
    __syncthreads();
}
__device__ __forceinline__ void gla_sample_item(const Ctx& C, int item, LAS unsigned char* lds, int tid) {
    const int s = item >> 2, h = item & 3, m = MPROMPT + s, wave = tid >> 6, lane = tid & 63;
    LAS float* av = (LAS float*)lds; LAS float* qs = av + 128; LAS float* kk = av + 256; LAS float* vv = av + 384; LAS float* part = (LAS float*)(lds + 4096);
    const bf16* zr = C.Z + (size_t)m * NZ;
    if (tid < 128) { float g = C.b_gk[h * 128 + tid];
#pragma unroll
        for (int r = 0; r < 16; ++r) g += C.GKLR[(size_t)m * 16 + r] * C.w_gk[r * 512 + h * 128 + tid];
        av[tid] = __expf(logsig(g) * (1.0f / 16.0f)); qs[tid] = bf2f(zr[ZQ + h * 128 + tid]) * 0.08838834764831845f; kk[tid] = bf2f(zr[ZK + h * 128 + tid]); }
    else if (tid < 384) vv[tid - 128] = bf2f(zr[ZV + h * 256 + tid - 128]);
    __syncthreads();
    const f32x4 v4 = ((const LAS f32x4*)vv)[lane]; f32x4 o = (f32x4){0.f, 0.f, 0.f, 0.f};
    const f32x4* S0 = (const f32x4*)(C.st_gla + (size_t)item * 128 * 256); f32x4* So = (f32x4*)(C.out + OUT_GLAS + (size_t)item * 128 * 256);
    f32x4 s0v[16];
#pragma unroll
    for (int it = 0; it < 16; ++it) s0v[it] = __builtin_nontemporal_load(S0 + (it * 8 + wave) * 64 + lane);
#pragma unroll
    for (int it = 0; it < 16; ++it) { const int k = it * 8 + wave; const f32x4 s0 = s0v[it]; const f32x4 sn = s0 * av[k] + v4 * kk[k]; __builtin_nontemporal_store(sn, So + k * 64 + lane); o += sn * qs[k]; }
    ((LAS f32x4*)(part + wave * 256))[lane] = o;
    __syncthreads();
    if (wave == 0) { f32x4 t = (f32x4){0.f, 0.f, 0.f, 0.f};
#pragma unroll
        for (int w = 0; w < 8; ++w) t += ((const LAS f32x4*)(part + w * 256))[lane];
        const float ss = wave_sum((t[0] * t[0] + t[1] * t[1]) + (t[2] * t[2] + t[3] * t[3]));
        const float rstd = 1.0f / sqrtf(ss * (1.0f / 256.0f) + EPS);
        const f32x4 wn = *(const f32x4*)(C.w_gn + 4 * lane); const u32x2 gw = *(const u32x2*)(zr + ZG + h * 256 + 4 * lane);
        const float g0 = bf_lo(gw.x), g1 = bf_hi(gw.x), g2 = bf_lo(gw.y), g3 = bf_hi(gw.y);
        *(u32x2*)(C.X3 + (size_t)m * D + h * 256 + 4 * lane) = (u32x2){pk2(t[0] * rstd * wn[0] * siluf(g0), t[1] * rstd * wn[1] * siluf(g1)), pk2(t[2] * rstd * wn[2] * siluf(g2), t[3] * rstd * wn[3] * siluf(g3))}; }
    __syncthreads();
}
__device__ __forceinline__ void conv_phase(const Ctx& C, int tid) {
    for (int idx = blockIdx.x * 512 + tid; idx < 1024 * 128; idx += gridDim.x * 512) {
        const int c8 = (idx & 127) * 8, seg = idx >> 7, m0 = seg * 16, tpos0 = m0 & (TSEQ - 1);
        float w0[8], w1[8], w2[8], u1[8], u2[8];
#pragma unroll
        for (int e = 0; e < 8; ++e) { w0[e] = C.w_conv[c8 + e]; w1[e] = C.w_conv[D + c8 + e]; w2[e] = C.w_conv[2 * D + c8 + e]; u1[e] = 0.f; u2[e] = 0.f; }
        if (tpos0 != 0) { float ca[8], xa[8]; const bf16* zr = C.Z + (size_t)(m0 - 1) * NZ;
            unpack8(*(const u32x4*)(zr + ZC + c8), ca); unpack8(*(const u32x4*)(zr + ZX + c8), xa);
#pragma unroll
            for (int e = 0; e < 8; ++e) u1[e] = ca[e] * xa[e];
            unpack8(*(const u32x4*)(zr - NZ + ZC + c8), ca); unpack8(*(const u32x4*)(zr - NZ + ZX + c8), xa);
#pragma unroll
            for (int e = 0; e < 8; ++e) u2[e] = ca[e] * xa[e]; }
#pragma unroll
        for (int rr = 0; rr < 16; rr += 4) {
            u32x4 vb[4], vc[4], vx[4];
#pragma unroll
            for (int i = 0; i < 4; ++i) { const bf16* zr = C.Z + (size_t)(m0 + rr + i) * NZ; vb[i] = __builtin_nontemporal_load((const u32x4*)(zr + ZB + c8)); vc[i] = __builtin_nontemporal_load((const u32x4*)(zr + ZC + c8)); vx[i] = __builtin_nontemporal_load((const u32x4*)(zr + ZX + c8)); }
#pragma unroll
            for (int i = 0; i < 4; ++i) { const int m = m0 + rr + i, tpos = tpos0 + rr + i; float ba[8], ca[8], xa[8], o[8], u0[8];
                unpack8(vb[i], ba); unpack8(vc[i], ca); unpack8(vx[i], xa);
#pragma unroll
                for (int e = 0; e < 8; ++e) { u0[e] = ca[e] * xa[e]; o[e] = ba[e] * (w0[e] * u2[e] + w1[e] * u1[e] + w2[e] * u0[e]); u2[e] = u1[e]; u1[e] = u0[e]; }
                __builtin_nontemporal_store(pack8(o), (u32x4*)(C.X2 + (size_t)m * D + c8));
                if (tpos >= TSEQ - 2) { float* dst = C.out + OUT_CONVP + ((size_t)(m >> 11) * 2 + (tpos - (TSEQ - 2))) * D + c8;
                    *(f32x4*)dst = (f32x4){u0[0], u0[1], u0[2], u0[3]}; *(f32x4*)(dst + 4) = (f32x4){u0[4], u0[5], u0[6], u0[7]}; } }
        }
    }
    for (int idx = blockIdx.x * 512 + tid; idx < NSAMP * 128; idx += gridDim.x * 512) {
        const int s = idx >> 7, c8 = (idx & 127) * 8, m = MPROMPT + s;
        const bf16* zr = C.Z + (size_t)m * NZ;
        float ba[8], ca[8], xa[8], o[8];
        unpack8(*(const u32x4*)(zr + ZB + c8), ba); unpack8(*(const u32x4*)(zr + ZC + c8), ca); unpack8(*(const u32x4*)(zr + ZX + c8), xa);
        const float* b0 = C.st_conv + ((size_t)s * 2 + 0) * D + c8; const float* b1 = b0 + D;
        float* d0 = C.out + OUT_CONVS + ((size_t)s * 2 + 0) * D + c8; float* d1 = d0 + D;
#pragma unroll
        for (int e = 0; e < 8; ++e) { const float u0 = ca[e] * xa[e], p0 = b0[e], p1 = b1[e];
            o[e] = ba[e] * (C.w_conv[c8 + e] * p0 + C.w_conv[D + c8 + e] * p1 + C.w_conv[2 * D + c8 + e] * u0); d0[e] = p1; d1[e] = u0; }
        *(u32x4*)(C.X2 + (size_t)m * D + c8) = pack8(o);
    }
}

__device__ __forceinline__ void gla_scan_item(const Ctx& C, int item, LAS unsigned char* lds, int tid) {
    const int jx = item >> 3, bh = (item & 7) * 4 + (jx >> 3), sl = jx & 7, b = bh >> 2, h = bh & 3;
    LAS bf16* Aq = (LAS bf16*)lds;
    LAS bf16* Bc = (LAS bf16*)(lds + 25600);
    LAS bf16* Kt = (LAS bf16*)(lds + 38400);
    const int wave = tid >> 6, lane = tid & 63, l15 = lane & 15, quad = lane >> 4;
    f32x4 S[2] = {(f32x4){0.f, 0.f, 0.f, 0.f}, (f32x4){0.f, 0.f, 0.f, 0.f}};
    *(LAS u32x4*)(Bc + (tid >> 4) * 200 + (tid & 15) * 8) = (u32x4){0u, 0u, 0u, 0u};
    u32x4 rq0A, rq1A, rsA, rk0A, rk1A, rvA = (u32x4){0u, 0u, 0u, 0u}; f32x4 rdA;
    u32x4 rq0B, rq1B, rsB, rk0B, rk1B, rvB = (u32x4){0u, 0u, 0u, 0u}; f32x4 rdB;
#define SCAN_LOAD(X, n) do { const size_t itn = (size_t)bh * 32 + (n); const size_t r0 = (size_t)b * TSEQ + (size_t)(n) * 64; \
        rq0##X = *(const u32x4*)(C.QT + (r0 + (tid >> 4)) * 512 + h * 128 + (tid & 15) * 8); rq1##X = *(const u32x4*)(C.QT + (r0 + 32 + (tid >> 4)) * 512 + h * 128 + (tid & 15) * 8); \
        rs##X = *(const u32x4*)(C.SC + (itn * 64 + (tid >> 3)) * 64 + (tid & 7) * 8); \
        rk0##X = *(const u32x4*)(C.KHT + (itn * 128 + (tid >> 3)) * 64 + (tid & 7) * 8); rk1##X = *(const u32x4*)(C.KHT + (itn * 128 + 64 + (tid >> 3)) * 64 + (tid & 7) * 8); \
        rv##X = *(const u32x4*)(C.Z + (r0 + ((tid & 255) >> 2)) * NZ + ZV + h * 256 + sl * 32 + (tid & 3) * 8); \
        rd##X = *(const f32x4*)(C.DBUF + itn * 128 + wave * 16 + quad * 4); } while (0)
#define SCAN_STEP(X, n) do { \
        *(LAS u32x4*)(Aq + (tid >> 4) * 200 + (tid & 15) * 8) = rq0##X; *(LAS u32x4*)(Aq + (32 + (tid >> 4)) * 200 + (tid & 15) * 8) = rq1##X; \
        *(LAS u32x4*)(Aq + (tid >> 3) * 200 + 128 + (tid & 7) * 8) = rs##X; \
        *(LAS u32x4*)(Kt + (tid >> 3) * 72 + (tid & 7) * 8) = rk0##X; *(LAS u32x4*)(Kt + (64 + (tid >> 3)) * 72 + (tid & 7) * 8) = rk1##X; \
        if (tid < 256) { const int t = tid >> 2, c = (tid & 3) * 8; LAS bf16* d = Bc + c * 200 + 128 + t; \
            d[0] = (bf16)(rv##X.x & 0xffffu); d[200] = (bf16)(rv##X.x >> 16); d[400] = (bf16)(rv##X.y & 0xffffu); d[600] = (bf16)(rv##X.y >> 16); \
            d[800] = (bf16)(rv##X.z & 0xffffu); d[1000] = (bf16)(rv##X.z >> 16); d[1200] = (bf16)(rv##X.w & 0xffffu); d[1400] = (bf16)(rv##X.w >> 16); } \
        const f32x4 dcur = rd##X; \
        const size_t tok0 = (size_t)b * TSEQ + (size_t)(n) * 64; \
        if ((n) + 2 < 32) SCAN_LOAD(X, (n) + 2); \
        __syncthreads(); \
        { const int vt = wave & 1, tt = wave >> 1; f32x4 acc = (f32x4){0.f, 0.f, 0.f, 0.f}; \
          _Pragma("unroll") for (int kk = 0; kk < 6; ++kk) { const bf16x8 a = *(const LAS bf16x8*)(Bc + (vt * 16 + l15) * 200 + kk * 32 + quad * 8), bq = *(const LAS bf16x8*)(Aq + (tt * 16 + l15) * 200 + kk * 32 + quad * 8); \
              acc = __builtin_amdgcn_mfma_f32_16x16x32_bf16(a, bq, acc, 0, 0, 0); } \
          *(u32x2*)(C.X4 + (tok0 + tt * 16 + l15) * D + h * 256 + sl * 32 + vt * 16 + quad * 4) = (u32x2){pk2(acc[0], acc[1]), pk2(acc[2], acc[3])}; } \
        _Pragma("unroll") for (int v2 = 0; v2 < 2; ++v2) { S[v2] = S[v2] * dcur; \
            _Pragma("unroll") for (int kk = 0; kk < 2; ++kk) { const bf16x8 a = *(const LAS bf16x8*)(Kt + (wave * 16 + l15) * 72 + kk * 32 + quad * 8), bq = *(const LAS bf16x8*)(Bc + (v2 * 16 + l15) * 200 + 128 + kk * 32 + quad * 8); \
                S[v2] = __builtin_amdgcn_mfma_f32_16x16x32_bf16(a, bq, S[v2], 0, 0, 0); } } \
        __syncthreads(); \
        _Pragma("unroll") for (int v2 = 0; v2 < 2; ++v2) *(LAS u32x2*)(Bc + (v2 * 16 + l15) * 200 + wave * 16 + quad * 4) = (u32x2){pk2(S[v2][0], S[v2][1]), pk2(S[v2][2], S[v2][3])}; \
    } while (0)
    SCAN_LOAD(A, 0); SCAN_LOAD(B, 1);
#pragma unroll
    for (int n = 0; n < 32; n += 2) { SCAN_STEP(A, n); SCAN_STEP(B, n + 1); }
#undef SCAN_STEP
#undef SCAN_LOAD
    float* So = C.out + OUT_GLAP + ((size_t)bh * 128 + wave * 16 + quad * 4) * 256 + sl * 32 + l15;
#pragma unroll
    for (int v2 = 0; v2 < 2; ++v2)
#pragma unroll
        for (int j = 0; j < 4; ++j) So[(size_t)j * 256 + v2 * 16] = S[v2][j];
    __syncthreads();
}

__device__ __forceinline__ void p4_onorm(const Ctx& C, int tid) {
    const int wave = tid >> 6, lane = tid & 63, gw = blockIdx.x * 8 + wave, NGW = gridDim.x * 8;
    const f32x4 wn = *(const f32x4*)(C.w_gn + 4 * lane);
    for (int m0 = gw; m0 < MPROMPT; m0 += 4 * NGW) {
        u32x2 ov[4][4], gv[4][4];
#pragma unroll
        for (int r = 0; r < 4; ++r) { const int m = m0 + r * NGW;
#pragma unroll
            for (int j = 0; j < 4; ++j) { ov[r][j] = (u32x2){0u, 0u}; gv[r][j] = (u32x2){0u, 0u};
                if (m < MPROMPT) { ov[r][j] = __builtin_nontemporal_load((const u32x2*)(C.X4 + (size_t)m * D + 4 * lane + 256 * j)); gv[r][j] = __builtin_nontemporal_load((const u32x2*)(C.Z + (size_t)m * NZ + ZG + 4 * lane + 256 * j)); } } }
#pragma unroll
        for (int r = 0; r < 4; ++r) { const int m = m0 + r * NGW; if (m >= MPROMPT) continue;
#pragma unroll
            for (int j = 0; j < 4; ++j) { const u32x2 ow = ov[r][j], gw2 = gv[r][j];
                const float o0 = bf_lo(ow.x), o1 = bf_hi(ow.x), o2 = bf_lo(ow.y), o3 = bf_hi(ow.y);
                const float rstd = 1.0f / sqrtf(wave_sum((o0 * o0 + o1 * o1) + (o2 * o2 + o3 * o3)) * (1.0f / 256.0f) + EPS);
                *(u32x2*)(C.X3 + (size_t)m * D + 4 * lane + 256 * j) = (u32x2){pk2(o0 * rstd * wn[0] * siluf(bf_lo(gw2.x)), o1 * rstd * wn[1] * siluf(bf_hi(gw2.x))), pk2(o2 * rstd * wn[2] * siluf(bf_lo(gw2.y)), o3 * rstd * wn[3] * siluf(bf_hi(gw2.y)))}; } }
    }
}
template <int MODE> __device__ __forceinline__ void ew_rows(const Ctx& C, int tid) {
    const int wave = tid >> 6, lane = tid & 63, gw = blockIdx.x * 8 + wave, NGW = gridDim.x * 8;
    const float* wsc = MODE == 0 ? C.w_post : MODE == 1 ? C.w_fpost : C.w_ppost;
    const bf16* baseb = MODE == 1 ? C.HB : C.X1;
    f32x4 wv[4], wf[4];
#pragma unroll
    for (int j = 0; j < 4; ++j) { wv[j] = *(const f32x4*)(wsc + 4 * lane + 256 * j); wf[j] = MODE == 0 ? *(const f32x4*)(C.w_fpre + 4 * lane + 256 * j) : (f32x4){1.f, 1.f, 1.f, 1.f}; }
    const float* PARTS = C.PART + (WS_PARTS - WS_PART) / 4;
    float pA[2], pB[2]; u32x2 svA[2][4], svB[2][4], bbA[2][4], bbB[2][4]; f32x4 bvA[2][4], bvB[2][4];
#define EW_LOAD(X, g) do { _Pragma("unroll") for (int r = 0; r < 2; ++r) { const int m_ = gwx + NGW * (2 * (g) + r), m = m_ < MTOK ? m_ : MTOK - 1; \
            const float* pp = m >= MPROMPT ? PARTS + (size_t)lane * NSAMP + (m - MPROMPT) : C.PART + (size_t)(lane & 15) * MP + m; \
            const float pv = *pp; p##X[r] = (m < MPROMPT && lane >= 16) ? 0.f : pv; \
            const float* bp = m < MPROMPT ? C.xp + (size_t)m * D : C.xs + (size_t)(m - MPROMPT) * D; \
            _Pragma("unroll") for (int j = 0; j < 4; ++j) { const int c = 4 * lane + 256 * j; sv##X[r][j] = __builtin_nontemporal_load((const u32x2*)(C.X2 + (size_t)m * D + c)); \
                if (MODE == 0) bv##X[r][j] = __builtin_nontemporal_load((const f32x4*)(bp + c)); else bb##X[r][j] = __builtin_nontemporal_load((const u32x2*)(baseb + (size_t)m * D + c)); } } } while (0)
#define EW_COMP(X, g) do { _Pragma("unroll") for (int r = 0; r < 2; ++r) { const int m = gwx + NGW * (2 * (g) + r); \
            const float rs = 1.0f / sqrtf(wave_sum(p##X[r]) * (1.0f / D) + EPS); f32x4 hv[4]; float s = 0.f; \
            _Pragma("unroll") for (int j = 0; j < 4; ++j) { const u32x2 w = sv##X[r][j]; const f32x4 t = (f32x4){bf_lo(w.x), bf_hi(w.x), bf_lo(w.y), bf_hi(w.y)}; \
                f32x4 bs; if (MODE == 0) bs = bv##X[r][j]; else { const u32x2 bw = bb##X[r][j]; bs = (f32x4){bf_lo(bw.x), bf_hi(bw.x), bf_lo(bw.y), bf_hi(bw.y)}; } \
                hv[j] = bs + t * rs * wv[j]; s += (hv[j][0] * hv[j][0] + hv[j][1] * hv[j][1]) + (hv[j][2] * hv[j][2] + hv[j][3] * hv[j][3]); } \
            float rstd = 1.0f; if (MODE == 0) rstd = 1.0f / sqrtf(wave_sum(s) * (1.0f / D) + EPS); \
            if (m < MTOK) { _Pragma("unroll") for (int j = 0; j < 4; ++j) { const int c = 4 * lane + 256 * j; \
                if (MODE == 2) __builtin_nontemporal_store(hv[j], (f32x4*)(C.out + OUT_Y + (size_t)m * D + c)); \
                else { if (MODE == 0) __builtin_nontemporal_store((u32x2){pk2(hv[j][0], hv[j][1]), pk2(hv[j][2], hv[j][3])}, (u32x2*)(C.HB + (size_t)m * D + c)); \
                    const f32x4 o = hv[j] * rstd * wf[j]; *(u32x2*)(C.X1 + (size_t)m * D + c) = (u32x2){pk2(o[0], o[1]), pk2(o[2], o[3])}; } } } } } while (0)
    for (int gwx = gw; gwx < MTOK; gwx += 10 * NGW) {
    EW_LOAD(A, 0); EW_LOAD(B, 1); EW_COMP(A, 0); EW_LOAD(A, 2); EW_COMP(B, 1); EW_LOAD(B, 3); EW_COMP(A, 2); EW_LOAD(A, 4); EW_COMP(B, 3); EW_COMP(A, 4);
    }
#undef EW_LOAD
#undef EW_COMP
}

#define XB_TMO      128
#define XB_XCNT(j)  (256  + 64 * (j))
#define XB_XSUB(j)  (1280 + 64 * (j))
#define XB_XGEN(j)  (2304 + 64 * (j))
#define XB_TOP      3328
#define XB_TOPGEN   3392
#define XCD_BAR_WORDS 3456
#define XB_SPIN_CAP (1u << 18)

__device__ __forceinline__ unsigned xb_ld(unsigned* p)              { return __hip_atomic_load(p, __ATOMIC_RELAXED, __HIP_MEMORY_SCOPE_AGENT); }
__device__ __forceinline__ unsigned xb_add(unsigned* p, unsigned v) { return __hip_atomic_fetch_add(p, v, __ATOMIC_RELAXED, __HIP_MEMORY_SCOPE_AGENT); }
__device__ __forceinline__ unsigned xb_xcc_id() { return (unsigned)__builtin_amdgcn_s_getreg((3 << 11) | 20) & 0xFu; }
#define XB_SPIN(cond, bar) do { unsigned _sp = 0; while (cond) { __builtin_amdgcn_s_sleep(1); \
    if ((++_sp & 255u) == 0u) { if (xb_ld(&(bar)[XB_TMO])) break; if (_sp > XB_SPIN_CAP) { atomicAdd(&(bar)[XB_TMO], 1u); break; } } } } while (0)

struct XcdBarrier {
    unsigned* bar; unsigned x;
    volatile LAS unsigned* st;
};

__device__ __forceinline__ XcdBarrier xcd_barrier_post(unsigned* bar, volatile LAS unsigned* st) {
    XcdBarrier b; b.bar = bar; b.x = xb_xcc_id(); b.st = st;
    if (threadIdx.x == 0) (void)xb_add(&bar[XB_XCNT(b.x)], 1u);
    return b;
}
__device__ __forceinline__ void xcd_barrier_complete(unsigned* bar, unsigned x, unsigned& nloc, unsigned& nx) {
    const unsigned G = gridDim.x * gridDim.y * gridDim.z;
    unsigned sum, cnt, mine, sp = 0u;
    for (;;) {
        sum = 0u; cnt = 0u; mine = 0u;
#pragma unroll
        for (unsigned j = 0; j < 16; ++j) { const unsigned c = xb_ld(&bar[XB_XCNT(j)]); sum += c; cnt += (c > 0u) ? 1u : 0u; mine = (j == x) ? c : mine; }
        if (sum == G) break;
        __builtin_amdgcn_s_sleep(1);
        if ((++sp & 255u) == 0u) { if (xb_ld(&bar[XB_TMO])) break; if (sp > XB_SPIN_CAP) { atomicAdd(&bar[XB_TMO], 1u); break; } }
    }
    nloc = mine > 0u ? mine : 1u; nx = cnt > 0u ? cnt : 1u;
}

__device__ __forceinline__ void xcd_barrier(const XcdBarrier& b) {
    asm volatile("s_waitcnt vmcnt(0)" ::: "memory");
    __syncthreads();
    if (threadIdx.x == 0) {
        unsigned* bar = b.bar;
        __builtin_amdgcn_s_waitcnt(0);
        unsigned nloc = b.st[0], nx = b.st[1];
        if (nloc == 0u) { xcd_barrier_complete(bar, b.x, nloc, nx); b.st[0] = nloc; b.st[1] = nx; }
        const unsigned old = xb_add(&bar[XB_XSUB(b.x)], 1u);
        const unsigned gen = old / nloc;
        if (old + 1u == (gen + 1u) * nloc) {
            __builtin_amdgcn_fence(__ATOMIC_RELEASE, "agent");
            asm volatile("s_waitcnt vmcnt(0)" ::: "memory");
            const unsigned og = xb_add(&bar[XB_TOP], 1u);
            const unsigned tg = og / nx;
            if (og + 1u == (tg + 1u) * nx) xb_add(&bar[XB_TOPGEN], 1u);
            else XB_SPIN(xb_ld(&bar[XB_TOPGEN]) == tg, bar);
            __builtin_amdgcn_fence(__ATOMIC_ACQUIRE, "agent");
            xb_add(&bar[XB_XGEN(b.x)], 1u);
            asm volatile("s_waitcnt vmcnt(0)" ::: "memory");
        } else {
            XB_SPIN(xb_ld(&bar[XB_XGEN(b.x)]) == gen, bar);
            __builtin_amdgcn_fence(__ATOMIC_ACQUIRE, "agent");
            asm volatile("s_waitcnt vmcnt(0)" ::: "memory");
        }
    }
    __syncthreads();
}


constexpr int NPHASE = 13;
__global__ void __launch_bounds__(512, 2) fwd_mega(Args a) {
    extern __shared__ __attribute__((aligned(16))) unsigned char lds_raw[];
    LAS unsigned char* lds = (LAS unsigned char*)lds_raw;
    const int tid = threadIdx.x, G = gridDim.x, bx = blockIdx.x;
    Ctx C;
    C.xp = a.in[0]; C.xs = a.in[1]; C.st_conv = a.in[2]; C.st_gla = a.in[3]; C.pp = a.in[4]; C.ps = a.in[5]; C.w_pre = a.in[6]; C.w_in = a.in[7]; C.w_conv = a.in[8]; C.w_a = a.in[9];
    C.w_gk = a.in[10]; C.b_gk = a.in[11]; C.w_gn = a.in[12]; C.w_b = a.in[13]; C.w_o = a.in[14]; C.w_post = a.in[15]; C.w_fpre = a.in[16]; C.w_fg = a.in[17]; C.w_fu = a.in[18]; C.w_fd = a.in[19];
    C.w_fpost = a.in[20]; C.w_pp = a.in[21]; C.w_pg = a.in[22]; C.w_ppost = a.in[23]; C.out = a.out;
    unsigned char* ws = a.ws;
    C.WIN = (bf16*)(ws + WS_WIN); C.WA = (bf16*)(ws + WS_WA); C.WB = (bf16*)(ws + WS_WB); C.WO = (bf16*)(ws + WS_WO); C.WPG = (bf16*)(ws + WS_WPG); C.WPP = (bf16*)(ws + WS_WPP);
    C.WGU = (bf16*)(ws + WS_WGU); C.WD = (bf16*)(ws + WS_WD); C.PB = (bf16*)(ws + WS_PB); C.X1 = (bf16*)(ws + WS_X1); C.X2 = (bf16*)(ws + WS_X2); C.X3 = (bf16*)(ws + WS_X3); C.X4 = (bf16*)(ws + WS_X4);
    C.Z = (bf16*)(ws + WS_Z); C.HID = (bf16*)(ws + WS_HID); C.KHT = (bf16*)(ws + WS_KHT); C.SC = (bf16*)(ws + WS_SC);
    C.GKLR = (float*)(ws + WS_GKLR); C.PART = (float*)(ws + WS_PART); C.DBUF = (float*)(ws + WS_DBUF); C.HB = (bf16*)(ws + WS_H); C.QT = (bf16*)(ws + WS_QT); C.WGK = (bf16*)(ws + WS_WGK);
    const int lo = a.ph_lo, hi = a.ph_hi;
#define IN(k) (lo <= (k) && (k) < hi)
    if (tid < 4) ((LAS unsigned*)(lds + LDS_BARST))[tid] = 0u;
    __syncthreads();
    const XcdBarrier bar = xcd_barrier_post((unsigned*)(ws + WS_CTL), (volatile LAS unsigned*)(lds + LDS_BARST));
    if (lo == 0x7fffffff) cg::this_grid().sync();
#define SEAM(k) do { if (IN(k) && IN((k) + 1)) xcd_barrier(bar); } while (0)
#define GEMM(EPI, Aptr, Bptr, Mv, Nv, Kv, Eobj) do { pg8::Gemm g{(const pg8::bf16_t*)(Aptr), (const pg8::bf16_t*)(Bptr), Mv, Nv, Kv}; pg8::StaticOrder S; S.init(Mv, Nv, G, bx); \
        pg8::gemm_phase<EPI, pg8::StaticOrder, true, true>(lds, g, S, Eobj); } while (0)

    if (IN(0)) for (int r_ = 0; r_ < REP[0]; ++r_) { p0_prologue(C, lds, tid); } SEAM(0);
    const size_t SR = (size_t)MPROMPT;
    float* PARTS = (float*)(ws + WS_PARTS);
    if (IN(1)) { const bool late_first = (bx >> 3) & 1;
        if (late_first) { int t_ = tid; asm volatile("" : "+v"(t_)); p0_late(C, lds, t_); __syncthreads(); }
        { EpiStore E{C.Z, NZ}; GEMM(EpiStore, C.X1, C.WIN, MPROMPT, NZ, D, E); }
        { MiniStore E{C.Z, NZ}; mini_gemm<false>(C.X1, MPROMPT, 1, C.WIN, D, NZ / 16, 0, E, lds, tid); }
        { MiniF32 E{C.GKLR, 16}; mini_gemm<false>(C.X1, 0, MTOK / 128, C.WGK, D, 1, 64, E, lds, tid); }
        if (!late_first) { int t_ = tid; asm volatile("" : "+v"(t_)); p0_late(C, lds, t_); } } SEAM(1);
    if (IN(2)) for (int r_ = 0; r_ < REP[2]; ++r_) {
        if ((bx >> 3) & 1) { conv_phase(C, tid); for (int it = bx; it < NSAMP * 4; it += G) gla_sample_item(C, it, lds, tid); }
        for (int it = bx; it < 1024; it += G) gla_prep_item(C, it, lds, tid);
        if (!((bx >> 3) & 1)) { for (int it = bx; it < NSAMP * 4; it += G) gla_sample_item(C, it, lds, tid); conv_phase(C, tid); }
    } SEAM(2);
    if (IN(3)) for (int r_ = 0; r_ < REP[3]; ++r_) { for (int it = bx; it < 256; it += G) gla_scan_item(C, it, lds, tid); } SEAM(3);
    if (IN(4)) { const bool gemm_first = !((bx >> 3) & 1);
        if (!gemm_first) { int t_ = tid; asm volatile("" : "+v"(t_)); p4_onorm(C, t_); }
        { EpiGate<false> E{C.Z + ZGA, nullptr, C.X1}; GEMM(EpiGate<false>, C.X2, C.WA, MPROMPT, D, D, E); }
        if (gemm_first) { int t_ = tid; asm volatile("" : "+v"(t_)); p4_onorm(C, t_); } } SEAM(4);
    if (IN(5)) for (int r_ = 0; r_ < REP[5]; ++r_) {
        { EpiGate<true> E{C.Z + ZGB, C.X1, C.X1}; GEMM(EpiGate<true>, C.X3, C.WB, MPROMPT, D, D, E); }
        { MiniGate<false> E{C.Z + ZGA, nullptr, C.X1}; mini_gemm<false, 2>(C.X2, MPROMPT, 1, C.WA, D, D / 16, 0, E, lds, tid); }
        { MiniGate<true> E{C.Z + ZGB, C.X1, C.X1}; mini_gemm<false, 2>(C.X3, MPROMPT, 1, C.WB, D, D / 16, 0, E, lds, tid); }
    } SEAM(5);
    if (IN(6)) for (int r_ = 0; r_ < REP[6]; ++r_) { { EpiSq<false> E{C.X2, nullptr, C.PART}; GEMM(EpiSq<false>, C.X1, C.WO, MPROMPT, D, D, E); }
        { MiniSq<false> E{C.X2, nullptr, PARTS}; mini_gemm<false, 2>(C.X1, MPROMPT, 1, C.WO, D, D / 16, 0, E, lds, tid); } } SEAM(6);
    if (IN(7)) for (int r_ = 0; r_ < REP[7]; ++r_) { ew_rows<0>(C, tid); } SEAM(7);
    if (IN(8)) for (int r_ = 0; r_ < REP[8]; ++r_) { { EpiSwiGLU E{C.HID}; GEMM(EpiSwiGLU, C.X1, C.WGU, MPROMPT, 2 * FF, D, E); }
        { MiniSwiGLU E{C.HID}; mini_gemm<true>(C.X1, MPROMPT, 1, C.WGU, D, FF / 16, G / 2, E, lds, tid); }
        { EpiStore E{C.X3, D}; pg8::Gemm g{(const pg8::bf16_t*)C.PB, (const pg8::bf16_t*)C.WPP, MPROMPT, D, PLE}; pg8::StaticOrder S;
          const int hG = G / 2; S.init(MPROMPT, D, G >= 2 ? hG : 1, G >= 2 ? (bx >= hG ? bx - hG : 0x3fffffff) : 0);
          pg8::gemm_phase<EpiStore, pg8::StaticOrder, true, true>(lds, g, S, E); } } SEAM(8);
    if (IN(9)) for (int r_ = 0; r_ < REP[9]; ++r_) { { EpiSq<false> E{C.X2, nullptr, C.PART}; GEMM(EpiSq<false>, C.HID, C.WD, MPROMPT, D, FF, E); }
        { MiniSq<false> E{C.X2, nullptr, PARTS}; mini_gemm<false, 2>(C.HID, MPROMPT, 1, C.WD, FF, D / 16, 0, E, lds, tid); } } SEAM(9);
    if (IN(10)) for (int r_ = 0; r_ < REP[10]; ++r_) { ew_rows<1>(C, tid); } SEAM(10);
    if (IN(11)) for (int r_ = 0; r_ < REP[11]; ++r_) {
        { EpiSq<true> E{C.X2, C.X3, C.PART}; GEMM(EpiSq<true>, C.X1, C.WPG, MPROMPT, D, D, E); }
        { MiniStore E{C.X3, D}; mini_gemm<false, 2>(C.PB, MPROMPT, 1, C.WPP, PLE, D / 16, 0, E, lds, tid); }
        { MiniSq<true> E{C.X2, C.X3, PARTS}; mini_gemm<false, 2>(C.X1, MPROMPT, 1, C.WPG, D, D / 16, 0, E, lds, tid); }
    } SEAM(11);
    if (IN(12)) for (int r_ = 0; r_ < REP[12]; ++r_) { ew_rows<2>(C, tid); }
}

extern "C" void kernel_launch(void* const* d_in, const int* in_sizes, int n_in, void* d_out, int out_size, void* d_ws, size_t ws_size, hipStream_t stream) {
    static int grid = 0;
    if (grid == 0) {
        int dev = 0, cus = 0, per_cu = 0;
        hipGetDevice(&dev); hipDeviceGetAttribute(&cus, hipDeviceAttributeMultiprocessorCount, dev);
        if (hipFuncSetAttribute((const void*)fwd_mega, hipFuncAttributeMaxDynamicSharedMemorySize, LDS_BYTES) != hipSuccess) { fprintf(stderr, "hipFuncSetAttribute failed\n"); }
        if (hipOccupancyMaxActiveBlocksPerMultiprocessor(&per_cu, (const void*)fwd_mega, 512, LDS_BYTES) != hipSuccess || per_cu < 1) { fprintf(stderr, "occupancy query: %d\n", per_cu); per_cu = 1; }
        (void)hipGetLastError();
        grid = cus * (per_cu > 1 ? 1 : per_cu);
        if (ws_size < WS_END) fprintf(stderr, "workspace too small: %zu < %zu\n", ws_size, (size_t)WS_END);
    }
    (void)hipMemsetAsync((char*)d_ws + WS_CTL, 0, CTL_BYTES, stream);
    Args a{};
    for (int i = 0; i < 24; ++i) a.in[i] = (const float*)d_in[i];
    a.out = (float*)d_out; a.ws = (unsigned char*)d_ws;
#if MK_PER_PHASE
    { const int plist[] = {PHASE_LIST}; for (int p : plist) { a.ph_lo = p; a.ph_hi = p + 1; hipLaunchKernelGGL(fwd_mega, dim3(grid), dim3(512), LDS_BYTES, stream, a); } }
#else
    a.ph_lo = 0; a.ph_hi = NPHASE;
    void* args[] = {&a};
    hipError_t e = hipLaunchCooperativeKernel((const void*)fwd_mega, dim3(grid), dim3(512), args, LDS_BYTES, stream);
    if (e != hipSuccess) fprintf(stderr, "cooperative launch failed: %s (grid %d)\n", hipGetErrorString(e), grid);
#endif
}
```

```cpp
#include <hip/hip_runtime.h>
#include <hip/hip_cooperative_groups.h>
#include <cstdio>
#include <cstdint>
namespace cg = cooperative_groups;
#ifndef REP_LIST
#define REP_LIST 1,1,1,1,1,1,1,1,1,1,1,1,1,1,1,1
#endif
#ifndef PHASE_LIST
#define PHASE_LIST 0,1,2,3,4,5,6,7,8,9,10,11,12
#endif
#ifndef MK_PER_PHASE
#define MK_PER_PHASE 0
#endif
namespace pg8 {
#define PG8_LAS __attribute__((address_space(3)))
typedef unsigned short bf16_t;
typedef short bf16x8 __attribute__((ext_vector_type(8)));
typedef float f32x4 __attribute__((ext_vector_type(4)));
typedef unsigned u32x4 __attribute__((ext_vector_type(4)));
constexpr int BM = 256, BK = 64, HALF = 128, HTB = HALF * BK * 2  , STAGE_BYTES = 8 * HTB, NXCD = 8, WGM = 8;

__host__ __device__ __forceinline__ int lds_byte(int r, int c) { const int st = (r >> 4) * 2 + (c >> 5), rr = r & 15, cc = c & 31, ob = rr * 64 + cc * 2; return st * 1024 + (ob ^ (((ob >> 9) & 1) << 5)); }
__host__ __device__ __forceinline__ void stage_rc(int b, int& R, int& C) { const int st = b / 1024, sb = b % 1024, swz = sb ^ (((sb >> 9) & 1) << 5); R = (st >> 1) * 16 + swz / 64; C = (st & 1) * 32 + (swz % 64) / 2; }
__host__ __device__ __forceinline__ int perm32(int rho) { const int n = rho >> 4, i = rho & 15; return 8 * (i >> 2) + 4 * n + (i & 3); }

struct Unit { int pm, pn; };
struct Gemm { const bf16_t* A; const bf16_t* Bt; int M, N, K; };

struct StaticOrder {
    int nM, nN, nwg, G, c;
    __host__ __device__ void init(int M, int N, int G_, int c_) { nM = M / BM; nN = N / BM; nwg = nM * nN; G = G_; c = c_; }
    __host__ __device__ bool next(int i, Unit& u) const {
        const long L = (long)i * G + c; if (L >= nwg) return false;
        int wgid = (int)L; { const int q = nwg / NXCD, r = nwg % NXCD, xcd = wgid % NXCD, off = wgid / NXCD; wgid = (xcd < r ? xcd * (q + 1) : r * (q + 1) + (xcd - r) * q) + off; }
        const int nig = WGM * nN, gid = wgid / nig, fm = gid * WGM, gsz = (nM - fm) < WGM ? (nM - fm) : WGM;
        u.pm = fm + ((wgid % nig) % gsz); u.pn = (wgid % nig) / gsz; return true;
    }
    __device__ __forceinline__ void a_ready(const Unit&) const {}
    __device__ __forceinline__ void done(const Unit&) const {}
};

__device__ __forceinline__ unsigned cvt_pk_bf16(float lo, float hi) { unsigned r; asm volatile("v_cvt_pk_bf16_f32 %0, %1, %2" : "=v"(r) : "v"(lo), "v"(hi)); return r; }
template <class Epi, class Sched, bool ALIGN_EPI = false, bool SP2 = false>
__device__ __forceinline__ void gemm_phase(PG8_LAS unsigned char* lds, const Gemm g, const Sched& S, const Epi& E) {
    const int tid = threadIdx.x, wid = __builtin_amdgcn_readfirstlane(tid >> 6), lane = tid & 63, wr = wid >> 2, wc = wid & 3, fr = lane & 15, fq = lane >> 4;
    const int K = g.K, nt = K / BK;
    unsigned voffA[2], voffB[2];
#pragma unroll
    for (int i = 0; i < 2; ++i) { int R, C; stage_rc(tid * 16 + i * 8192, R, C); const int Rb = Epi::PERM ? ((R & ~31) + perm32(R & 31)) : R;
        voffA[i] = (unsigned)(R * K + C) * 2u; voffB[i] = (unsigned)(Rb * K + C) * 2u; }
    const size_t kstep = (size_t)(BK * 2);
    const size_t hstep = (size_t)HALF * K * 2;
    const size_t tstep = 2 * hstep;
    const unsigned ldsw = (unsigned)wid * 1024u;
    const int aoff = lds_byte(wr * 64 + fr, fq * 8), boff = lds_byte(wc * 32 + fr, fq * 8);
#define PG8_SA(b, h) (((b) * 2 + (h)) * HTB)
#define PG8_SB(b, h) ((4 + (b) * 2 + (h)) * HTB)
#define PG8_STAGE(bufoff, gbase, voff) do { _Pragma("unroll") for (int _i = 0; _i < 2; ++_i) \
        __builtin_amdgcn_global_load_lds((const unsigned*)((const char*)(gbase) + (voff)[_i]), (PG8_LAS unsigned*)(lds + (bufoff) + ldsw + _i * 8192), 16, 0, 0); } while (0)
#define PG8_LDA(dst, b, h) do { _Pragma("unroll") for (int m = 0; m < 4; ++m) _Pragma("unroll") for (int k = 0; k < 2; ++k) dst[m][k] = *(const PG8_LAS bf16x8*)(lds + PG8_SA(b, h) + aoff + m * 2048 + k * 1024); } while (0)
#define PG8_LDB(dst, b, h) do { _Pragma("unroll") for (int n = 0; n < 2; ++n) _Pragma("unroll") for (int k = 0; k < 2; ++k) dst[n][k] = *(const PG8_LAS bf16x8*)(lds + PG8_SB(b, h) + boff + n * 2048 + k * 1024); } while (0)
#define PG8_MMA(ai, bj, At, Bt) do { __builtin_amdgcn_s_setprio(1); _Pragma("unroll") for (int m = 0; m < 4; ++m) _Pragma("unroll") for (int n = 0; n < 2; ++n) _Pragma("unroll") for (int k = 0; k < 2; ++k) \
        acc[ai][bj][m][n] = __builtin_amdgcn_mfma_f32_16x16x32_bf16(Bt[n][k], At[m][k], acc[ai][bj][m][n], 0, 0, 0); __builtin_amdgcn_s_setprio(0); } while (0)
#define PG8_WAIT_V(n) asm volatile("s_waitcnt vmcnt(" #n ")" ::: "memory")
#define PG8_WAIT_L(n) asm volatile("s_waitcnt lgkmcnt(" #n ")" ::: "memory")
#define PG8_BAR __builtin_amdgcn_s_barrier()
#define PG8_SCHED __builtin_amdgcn_sched_barrier(0)
    Unit cur, nxt; int ui = 0;
    if (!S.next(0, cur)) return;
    f32x4 acc[2][2][4][2];
#pragma unroll
    for (int a = 0; a < 2; ++a)
#pragma unroll
        for (int b = 0; b < 2; ++b)
#pragma unroll
            for (int m = 0; m < 4; ++m)
#pragma unroll
                for (int n = 0; n < 2; ++n) acc[a][b][m][n] = (f32x4){0.f, 0.f, 0.f, 0.f};
    bf16x8 At[4][2], B0[2][2], B1[2][2];
    const char* cA = (const char*)g.A + (size_t)cur.pm * tstep; const char* cB = (const char*)g.Bt + (size_t)cur.pn * tstep;
    S.a_ready(cur);
    if constexpr (SP2) {
        PG8_STAGE(PG8_SB(0, 0), cB, voffB); PG8_STAGE(PG8_SB(0, 1), cB + hstep, voffB); PG8_STAGE(PG8_SA(0, 0), cA, voffA); PG8_STAGE(PG8_SA(0, 1), cA + hstep, voffA);
        if (wr == 1) PG8_BAR;
        PG8_WAIT_V(2); PG8_BAR;
        PG8_STAGE(PG8_SB(1, 0), cB + kstep, voffB); PG8_STAGE(PG8_SA(1, 0), cA + kstep, voffA); PG8_STAGE(PG8_SB(1, 1), cB + hstep + kstep, voffB);
        PG8_WAIT_V(6); PG8_BAR;
    } else {
        PG8_STAGE(PG8_SB(0, 0), cB, voffB); PG8_STAGE(PG8_SA(0, 0), cA, voffA); PG8_STAGE(PG8_SB(0, 1), cB + hstep, voffB); PG8_STAGE(PG8_SA(0, 1), cA + hstep, voffA);
        if (wr == 1) PG8_BAR;
        PG8_WAIT_V(4); PG8_BAR;
        PG8_STAGE(PG8_SB(1, 0), cB + kstep, voffB); PG8_STAGE(PG8_SA(1, 0), cA + kstep, voffA); PG8_STAGE(PG8_SB(1, 1), cB + hstep + kstep, voffB);
        PG8_WAIT_V(6); PG8_BAR;
    }
    for (;;) {
        const bool has_next = S.next(ui + 1, nxt);
        const char* nA = has_next ? (const char*)g.A + (size_t)nxt.pm * tstep : cA; const char* nB = has_next ? (const char*)g.Bt + (size_t)nxt.pn * tstep : cB;
        for (int t = 0; t < nt; t += 2) {
            const bool last = (t == nt - 2);
            const char* a1 = cA + (size_t)(t + 1) * kstep;
            const char* a2 = last ? nA : cA + (size_t)(t + 2) * kstep; const char* b2 = last ? nB : cB + (size_t)(t + 2) * kstep;
            const char* a3 = a2 + kstep; const char* b3 = b2 + kstep;
            if (last && has_next) S.a_ready(nxt);
            if constexpr (SP2) {
            PG8_LDB(B0, 0, 0); PG8_LDB(B1, 0, 1); PG8_SCHED; PG8_LDA(At, 0, 0); PG8_STAGE(PG8_SA(1, 1), a1 + hstep, voffA);
            PG8_WAIT_V(8); PG8_WAIT_L(0); PG8_BAR; PG8_MMA(0, 0, At, B0); PG8_MMA(0, 1, At, B1); PG8_BAR; PG8_SCHED;
            PG8_LDA(At, 0, 1); PG8_STAGE(PG8_SB(0, 0), b2, voffB); PG8_STAGE(PG8_SB(0, 1), b2 + hstep, voffB); PG8_STAGE(PG8_SA(0, 0), a2, voffA);
            PG8_WAIT_V(8); PG8_WAIT_L(0); PG8_BAR; PG8_MMA(1, 0, At, B0); PG8_MMA(1, 1, At, B1); PG8_BAR; PG8_SCHED;
            PG8_LDB(B0, 1, 0); PG8_LDB(B1, 1, 1); PG8_SCHED; PG8_LDA(At, 1, 0); PG8_STAGE(PG8_SA(0, 1), a2 + hstep, voffA);
            PG8_WAIT_V(8); PG8_WAIT_L(0); PG8_BAR; PG8_MMA(0, 0, At, B0); PG8_MMA(0, 1, At, B1); PG8_BAR; PG8_SCHED;
            PG8_LDA(At, 1, 1); PG8_STAGE(PG8_SB(1, 0), b3, voffB); PG8_STAGE(PG8_SB(1, 1), b3 + hstep, voffB); PG8_STAGE(PG8_SA(1, 0), a3, voffA);
            PG8_WAIT_V(8); PG8_WAIT_L(0); PG8_BAR; PG8_MMA(1, 0, At, B0); PG8_MMA(1, 1, At, B1); PG8_BAR; PG8_SCHED;
            } else {
            PG8_LDB(B0, 0, 0); PG8_SCHED; PG8_LDA(At, 0, 0); PG8_STAGE(PG8_SA(1, 1), a1 + hstep, voffA);
            PG8_WAIT_L(8); PG8_BAR; PG8_WAIT_L(0); PG8_MMA(0, 0, At, B0); PG8_BAR; PG8_SCHED;
            PG8_LDB(B1, 0, 1); PG8_STAGE(PG8_SB(0, 0), b2, voffB);
            PG8_BAR; PG8_WAIT_L(0); PG8_MMA(0, 1, At, B1); PG8_BAR;
            PG8_LDA(At, 0, 1); PG8_STAGE(PG8_SA(0, 0), a2, voffA);
            PG8_BAR; PG8_WAIT_L(0); PG8_MMA(1, 0, At, B0); PG8_BAR; PG8_SCHED;
            PG8_STAGE(PG8_SB(0, 1), b2 + hstep, voffB);
            PG8_WAIT_V(6); PG8_BAR; PG8_MMA(1, 1, At, B1); PG8_BAR;
            PG8_LDB(B0, 1, 0); PG8_SCHED; PG8_LDA(At, 1, 0); PG8_STAGE(PG8_SA(0, 1), a2 + hstep, voffA);
            PG8_WAIT_L(8); PG8_BAR; PG8_WAIT_L(0); PG8_MMA(0, 0, At, B0); PG8_BAR; PG8_SCHED;
            PG8_LDB(B1, 1, 1); PG8_STAGE(PG8_SB(1, 0), b3, voffB);
            PG8_BAR; PG8_WAIT_L(0); PG8_MMA(0, 1, At, B1); PG8_BAR;
            PG8_LDA(At, 1, 1); PG8_STAGE(PG8_SA(1, 0), a3, voffA);
            PG8_BAR; PG8_WAIT_L(0); PG8_MMA(1, 0, At, B0); PG8_BAR; PG8_SCHED;
            PG8_STAGE(PG8_SB(1, 1), b3 + hstep, voffB);
            PG8_WAIT_V(6); PG8_BAR; PG8_MMA(1, 1, At, B1); PG8_BAR;
            }
        }
        if constexpr (ALIGN_EPI) { if (wr == 0) PG8_BAR; }
        if constexpr (!Epi::AFTER_DRAIN) { E(acc, cur, wr, wc, fr, fq); S.done(cur); }
        if (!has_next) break;
#pragma unroll
        for (int a = 0; a < 2; ++a)
#pragma unroll
            for (int b = 0; b < 2; ++b)
#pragma unroll
                for (int m = 0; m < 4; ++m)
#pragma unroll
                    for (int n = 0; n < 2; ++n) acc[a][b][m][n] = (f32x4){0.f, 0.f, 0.f, 0.f};
        cur = nxt; cA = nA; cB = nB; ++ui;
        if constexpr (ALIGN_EPI) { if (wr == 1) PG8_BAR; }
    }
    PG8_WAIT_V(0);
    if constexpr (!ALIGN_EPI) { if (wr == 0) PG8_BAR; }
    PG8_BAR;
    if constexpr (Epi::AFTER_DRAIN) { E.fused(acc, cur, wr, wc, fr, fq, lds, wid, lane); S.done(cur); }
#undef PG8_SA
#undef PG8_SB
#undef PG8_STAGE
#undef PG8_LDA
#undef PG8_LDB
#undef PG8_MMA
#undef PG8_WAIT_V
#undef PG8_WAIT_L
#undef PG8_BAR
#undef PG8_SCHED
}
}

#define LAS __attribute__((address_space(3)))
typedef unsigned short bf16;
typedef pg8::bf16x8 bf16x8;
typedef pg8::f32x4 f32x4;
typedef pg8::u32x4 u32x4;
typedef unsigned u32x2 __attribute__((ext_vector_type(2)));

constexpr int D = 1024, TSEQ = 2048, MPROMPT = 16384, NSAMP = 128, MTOK = MPROMPT + NSAMP, MP = 16640;
constexpr int NZ = 8192, ZB = 0, ZC = 1024, ZX = 2048, ZQ = 3072, ZK = 3584, ZV = 4096, ZG = 5120, ZGA = 6144, ZGB = 7168;
constexpr int FF = 2816, PLE = 256, NWIN = 8208, GKCOL = 6144;
constexpr float EPS = 1e-6f;
constexpr size_t MiB = 1u << 20;
constexpr size_t WS_WIN = 0, WS_WA = 16 * MiB, WS_WB = 18 * MiB, WS_WO = 20 * MiB, WS_WPG = 22 * MiB, WS_WPP = 24 * MiB, WS_WGU = 25 * MiB, WS_WD = 36 * MiB;
constexpr size_t WS_GKLR = 42 * MiB, WS_PART = 44 * MiB, WS_DBUF = 46 * MiB, WS_SC = 47 * MiB, WS_KHT = 55 * MiB, WS_PB = 71 * MiB;
constexpr size_t WS_X1 = 80 * MiB, WS_X2 = 113 * MiB, WS_X3 = 146 * MiB, WS_X4 = 179 * MiB, WS_Z = 212 * MiB, WS_HID = WS_Z, WS_H = WS_Z + 96 * MiB, WS_H2 = WS_Z + 164 * MiB, WS_QT = 472 * MiB, WS_END = 488 * MiB;
constexpr size_t OUT_Y = 0, OUT_CONVP = (size_t)MTOK * D, OUT_GLAP = OUT_CONVP + 8 * 2 * 1024, OUT_CONVS = OUT_GLAP + (size_t)8 * 4 * 128 * 256, OUT_GLAS = OUT_CONVS + (size_t)128 * 2 * 1024;
constexpr int LDS_BYTES = 131072 + 256, LDS_BARST = 131072;
constexpr size_t WS_CTL = 45 * MiB + 256 * 1024, CTL_BYTES = 16384;

struct Args { const float* in[24]; float* out; unsigned char* ws; int ph_lo, ph_hi; };
constexpr int REP[16] = {REP_LIST};

struct Ctx {
    const float *xp, *xs, *st_conv, *st_gla, *pp, *ps, *w_pre, *w_in, *w_conv, *w_a, *w_gk, *b_gk, *w_gn, *w_b, *w_o, *w_post, *w_fpre, *w_fg, *w_fu, *w_fd, *w_fpost, *w_pp, *w_pg, *w_ppost;
    float* out;
    bf16 *WIN, *WA, *WB, *WO, *WPG, *WPP, *WGU, *WD, *PB, *X1, *X2, *X3, *X4, *Z, *HID, *KHT, *SC;
    float *GKLR, *PART, *DBUF; bf16 *QT, *WGK, *HB;
};

__device__ __forceinline__ float wave_sum(float v) {
#pragma unroll
    for (int o = 1; o < 64; o <<= 1) v += __shfl_xor(v, o);
    return v;
}
typedef float f32x2_t __attribute__((ext_vector_type(2))); typedef __bf16 bf16x2_t __attribute__((ext_vector_type(2)));
__device__ __forceinline__ unsigned pk2(float lo, float hi) { f32x2_t v = {lo, hi}; bf16x2_t b = __builtin_convertvector(v, bf16x2_t); return __builtin_bit_cast(unsigned, b); }
__device__ __forceinline__ float bf_lo(unsigned w) { return __uint_as_float(w << 16); }
__device__ __forceinline__ float bf_hi(unsigned w) { return __uint_as_float(w & 0xffff0000u); }
__device__ __forceinline__ float bf2f(bf16 b) { return __uint_as_float(((unsigned)b) << 16); }
__device__ __forceinline__ bf16 f2bf(float f) { return (bf16)(pk2(f, 0.f) & 0xffffu); }
__device__ __forceinline__ float sigm(float x) { return __builtin_amdgcn_rcpf(1.0f + __expf(-x)); }
__device__ __forceinline__ float siluf(float x) { return x * sigm(x); }
__device__ __forceinline__ float logsig(float g) { return fminf(g, 0.f) - __logf(1.0f + __expf(-fabsf(g))); }
__device__ __forceinline__ void unpack8(const u32x4 w, float (&v)[8]) {
    v[0] = bf_lo(w.x); v[1] = bf_hi(w.x); v[2] = bf_lo(w.y); v[3] = bf_hi(w.y); v[4] = bf_lo(w.z); v[5] = bf_hi(w.z); v[6] = bf_lo(w.w); v[7] = bf_hi(w.w);
}
__device__ __forceinline__ u32x4 pack8(const float (&v)[8]) { u32x4 w; w.x = pk2(v[0], v[1]); w.y = pk2(v[2], v[3]); w.z = pk2(v[4], v[5]); w.w = pk2(v[6], v[7]); return w; }

struct EpiStore {
    static constexpr bool PERM = true, AFTER_DRAIN = false;
    bf16* O; int ldc;
    __device__ __forceinline__ void operator()(const f32x4 (&acc)[2][2][4][2], const pg8::Unit& u, int wr, int wc, int fr, int fq) const {
        const int row0 = u.pm * 256 + wr * 64 + fr, col0 = u.pn * 256 + wc * 32 + 8 * fq;
#pragma unroll
        for (int ai = 0; ai < 2; ++ai)
#pragma unroll
            for (int m = 0; m < 4; ++m) { bf16* rowp = O + (size_t)(row0 + ai * 128 + m * 16) * ldc + col0;
#pragma unroll
                for (int bj = 0; bj < 2; ++bj) { const f32x4 v0 = acc[ai][bj][m][0], v1 = acc[ai][bj][m][1];
                    u32x4 w; w.x = pk2(v0[0], v0[1]); w.y = pk2(v0[2], v0[3]); w.z = pk2(v1[0], v1[1]); w.w = pk2(v1[2], v1[3]);
                    *(u32x4*)(rowp + bj * 128) = w; } }
    }
};
template <bool HAS_ADD> struct EpiGate {
    static constexpr bool PERM = true, AFTER_DRAIN = false;
    const bf16* zg; const bf16* add; bf16* O;
    __device__ __forceinline__ void operator()(const f32x4 (&acc)[2][2][4][2], const pg8::Unit& u, int wr, int wc, int fr, int fq) const {
        const int row0 = u.pm * 256 + wr * 64 + fr, col0 = u.pn * 256 + wc * 32 + 8 * fq;
#pragma unroll
        for (int ai = 0; ai < 2; ++ai)
#pragma unroll
            for (int m = 0; m < 4; ++m) { const size_t row = (size_t)(row0 + ai * 128 + m * 16);
#pragma unroll
                for (int bj = 0; bj < 2; ++bj) { const int col = col0 + bj * 128;
                    float g[8]; unpack8(__builtin_nontemporal_load((const u32x4*)(zg + row * NZ + col)), g);
                    const f32x4 v0 = acc[ai][bj][m][0], v1 = acc[ai][bj][m][1];
                    float o[8] = {v0[0], v0[1], v0[2], v0[3], v1[0], v1[1], v1[2], v1[3]};
#pragma unroll
                    for (int e = 0; e < 8; ++e) o[e] *= sigm(g[e]);
                    if (HAS_ADD) { float ad[8]; unpack8(__builtin_nontemporal_load((const u32x4*)(add + row * D + col)), ad);
#pragma unroll
                        for (int e = 0; e < 8; ++e) o[e] += ad[e]; }
                    *(u32x4*)(O + row * D + col) = pack8(o); } }
    }
};
template <bool MULSIG> struct EpiSq {
    static constexpr bool PERM = true, AFTER_DRAIN = false;
    bf16* O; const bf16* mul; float* part;
    __device__ __forceinline__ void operator()(const f32x4 (&acc)[2][2][4][2], const pg8::Unit& u, int wr, int wc, int fr, int fq) const {
        const int row0 = u.pm * 256 + wr * 64 + fr, col0 = u.pn * 256 + wc * 32 + 8 * fq;
#pragma unroll
        for (int ai = 0; ai < 2; ++ai)
#pragma unroll
            for (int m = 0; m < 4; ++m) { const size_t row = (size_t)(row0 + ai * 128 + m * 16); float s = 0.f;
#pragma unroll
                for (int bj = 0; bj < 2; ++bj) { const int col = col0 + bj * 128;
                    const f32x4 v0 = acc[ai][bj][m][0], v1 = acc[ai][bj][m][1];
                    float o[8] = {v0[0], v0[1], v0[2], v0[3], v1[0], v1[1], v1[2], v1[3]};
                    if (MULSIG) { float p[8]; unpack8(__builtin_nontemporal_load((const u32x4*)(mul + row * D + col)), p);
#pragma unroll
                        for (int e = 0; e < 8; ++e) o[e] = p[e] * sigm(o[e]); }
#pragma unroll
                    for (int e = 0; e < 8; ++e) s += o[e] * o[e];
                    *(u32x4*)(O + row * D + col) = pack8(o); }
                s += __shfl_xor(s, 16); s += __shfl_xor(s, 32);
                if (fq == 0) part[(size_t)(u.pn * 4 + wc) * MP + row] = s; }
    }
};
struct EpiSwiGLU {
    static constexpr bool PERM = true, AFTER_DRAIN = false;
    bf16* Hd;
    __device__ __forceinline__ void operator()(const f32x4 (&acc)[2][2][4][2], const pg8::Unit& u, int wr, int wc, int fr, int fq) const {
        const int row0 = u.pm * 256 + wr * 64 + fr, col0 = u.pn * 128 + wc * 32 + 8 * fq;
#pragma unroll
        for (int ai = 0; ai < 2; ++ai)
#pragma unroll
            for (int m = 0; m < 4; ++m) { const size_t row = (size_t)(row0 + ai * 128 + m * 16);
                const f32x4 g0 = acc[ai][0][m][0], g1 = acc[ai][0][m][1], u0 = acc[ai][1][m][0], u1 = acc[ai][1][m][1];
                float o[8];
#pragma unroll
                for (int e = 0; e < 4; ++e) { o[e] = siluf(g0[e]) * u0[e]; o[4 + e] = siluf(g1[e]) * u1[e]; }
                *(u32x4*)(Hd + row * FF + col0) = pack8(o); }
    }
};


constexpr size_t WS_WGK = 45 * MiB + 768 * 1024;
constexpr size_t WS_PARTS = 45 * MiB + 512 * 1024;
template <bool TWO, int NRB = 8, class F>
__device__ __forceinline__ void mini_gemm(const bf16* A, int row0, int n_rb, const bf16* Bt, int K, int ncu, int rot, const F& epi, LAS unsigned char* lds, int tid) {
    const int wave = tid >> 6, lane = tid & 63, l15 = lane & 15, quad = lane >> 4, G = gridDim.x;
    const int nsw = K >> 8;
    constexpr int NSUB = 8 / NRB;
    LAS f32x4* red = (LAS f32x4*)lds;
    for (int u = (int)((blockIdx.x + rot) % G); u < n_rb * NSUB * ncu; u += G) {
        const int cu = u % ncu, t_ = u / ncu, rowb = row0 + (t_ / NSUB) * 128 + (t_ % NSUB) * (16 * NRB);
        const bf16* ap = A + (size_t)(rowb + l15) * K + wave * (K >> 3) + quad * 8;
        const int brow = TWO ? ((16 * cu) >> 7) * 256 + ((16 * cu) & 127) : 16 * cu;
        const bf16* bp = Bt + (size_t)(brow + l15) * K + wave * (K >> 3) + quad * 8;
        f32x4 acc0[NRB], acc1[NRB];
#pragma unroll
        for (int r = 0; r < NRB; ++r) { acc0[r] = (f32x4){0.f, 0.f, 0.f, 0.f}; acc1[r] = (f32x4){0.f, 0.f, 0.f, 0.f}; }
        constexpr int KS = TWO ? 2 : (NRB == 8 ? 4 : 12);
        for (int s0 = 0; s0 < nsw; s0 += KS) {
            bf16x8 a[KS][NRB], b[KS], c[KS];
#pragma unroll
            for (int s = 0; s < KS; ++s) { const bool on = s0 + s < nsw; const int ko = (s0 + s) * 32;
                b[s] = on ? *(const bf16x8*)(bp + ko) : (bf16x8){0, 0, 0, 0, 0, 0, 0, 0}; if (TWO) c[s] = on ? *(const bf16x8*)(bp + (size_t)128 * K + ko) : (bf16x8){0, 0, 0, 0, 0, 0, 0, 0};
#pragma unroll
                for (int r = 0; r < NRB; ++r) a[s][r] = on ? *(const bf16x8*)(ap + (size_t)(16 * r) * K + ko) : (bf16x8){0, 0, 0, 0, 0, 0, 0, 0}; }
#pragma unroll
            for (int s = 0; s < KS; ++s)
#pragma unroll
                for (int r = 0; r < NRB; ++r) { acc0[r] = __builtin_amdgcn_mfma_f32_16x16x32_bf16(b[s], a[s][r], acc0[r], 0, 0, 0); if (TWO) acc1[r] = __builtin_amdgcn_mfma_f32_16x16x32_bf16(c[s], a[s][r], acc1[r], 0, 0, 0); }
        }
        f32x4 t0 = (f32x4){0.f, 0.f, 0.f, 0.f}, t1 = (f32x4){0.f, 0.f, 0.f, 0.f};
#pragma unroll
        for (int r = 0; r < NRB; ++r) red[(wave * NRB + r) * 64 + lane] = acc0[r];
        __syncthreads();
        if (wave < NRB) {
#pragma unroll
            for (int s = 0; s < 8; ++s) t0 += red[(s * NRB + wave) * 64 + lane]; }
        __syncthreads();
        if (TWO) {
#pragma unroll
            for (int r = 0; r < NRB; ++r) red[(wave * NRB + r) * 64 + lane] = acc1[r];
            __syncthreads();
            if (wave < NRB) {
#pragma unroll
                for (int s = 0; s < 8; ++s) t1 += red[(s * NRB + wave) * 64 + lane]; }
            __syncthreads();
        }
        if (wave < NRB) epi(cu, rowb + 16 * wave + l15, 16 * cu + 4 * quad, t0, t1);
    }
}
struct MiniF32 { float* O; int ldc; __device__ __forceinline__ void operator()(int, int row, int col, const f32x4 v, const f32x4) const { *(f32x4*)(O + (size_t)row * ldc + col) = v; } };
__device__ __forceinline__ void st4(bf16* p, const f32x4 v) { *(u32x2*)p = (u32x2){pk2(v[0], v[1]), pk2(v[2], v[3])}; }
__device__ __forceinline__ f32x4 ld4(const bf16* p) { const u32x2 w = *(const u32x2*)p; return (f32x4){bf_lo(w.x), bf_hi(w.x), bf_lo(w.y), bf_hi(w.y)}; }
__device__ __forceinline__ f32x4 sig4(const f32x4 g) { return (f32x4){sigm(g[0]), sigm(g[1]), sigm(g[2]), sigm(g[3])}; }
struct MiniStore { bf16* O; int ldc; __device__ __forceinline__ void operator()(int, int row, int col, const f32x4 v, const f32x4) const { st4(O + (size_t)row * ldc + col, v); } };
template <bool HAS_ADD> struct MiniGate { const bf16* zg; const bf16* add; bf16* O;
    __device__ __forceinline__ void operator()(int, int row, int col, const f32x4 v, const f32x4) const { f32x4 o = sig4(ld4(zg + (size_t)row * NZ + col)) * v; if (HAS_ADD) o += ld4(add + (size_t)row * D + col); st4(O + (size_t)row * D + col, o); } };
template <bool MULSIG> struct MiniSq { bf16* O; const bf16* mul; float* parts;
    __device__ __forceinline__ void operator()(int u, int row, int col, const f32x4 v, const f32x4) const { f32x4 o = v; if (MULSIG) o = ld4(mul + (size_t)row * D + col) * sig4(v);
        st4(O + (size_t)row * D + col, o); float s = (o[0] * o[0] + o[1] * o[1]) + (o[2] * o[2] + o[3] * o[3]); s += __shfl_xor(s, 16); s += __shfl_xor(s, 32);
        if ((threadIdx.x & 63) < 16) parts[(size_t)u * NSAMP + (row - MPROMPT)] = s; } };
struct MiniSwiGLU { bf16* Hd; __device__ __forceinline__ void operator()(int, int row, int col, const f32x4 g, const f32x4 up) const { st4(Hd + (size_t)row * FF + col, (f32x4){siluf(g[0]) * up[0], siluf(g[1]) * up[1], siluf(g[2]) * up[2], siluf(g[3]) * up[3]}); } };

template <bool WT_NT = true>
__device__ __forceinline__ void p0_transpose_item(const float* W, int ldn, int k0, int nsrc0, bf16* WT, int K, int drow0, LAS float* scr, int lane) {
    float tv[32];
#pragma unroll
    for (int i = 0; i < 32; ++i) tv[i] = __builtin_nontemporal_load(W + (size_t)(k0 + 2 * i + (lane >> 5)) * ldn + nsrc0 + (lane & 31));
#pragma unroll
    for (int i = 0; i < 32; ++i) scr[(2 * i + (lane >> 5)) * 33 + (lane & 31)] = tv[i];
    asm volatile("s_waitcnt lgkmcnt(0)" ::: "memory");
    const int c = lane & 7;
#pragma unroll
    for (int j = 0; j < 4; ++j) { const int n = (lane >> 3) + 8 * j; const LAS float* s = scr + (8 * c) * 33 + n;
        u32x4 o; o.x = pk2(s[0 * 33], s[1 * 33]); o.y = pk2(s[2 * 33], s[3 * 33]); o.z = pk2(s[4 * 33], s[5 * 33]); o.w = pk2(s[6 * 33], s[7 * 33]);
        if (WT_NT) __builtin_nontemporal_store(o, (u32x4*)(WT + (size_t)(drow0 + n) * K + k0 + 8 * c)); else *(u32x4*)(WT + (size_t)(drow0 + n) * K + k0 + 8 * c) = o; }
    asm volatile("s_waitcnt lgkmcnt(0)" ::: "memory");
}
__device__ __forceinline__ void p0_items(const Ctx& C, LAS unsigned char* lds, int tid, bool late) {
    const int wave = tid >> 6, lane = tid & 63, gw = blockIdx.x * 8 + wave, NGW = gridDim.x * 8;
    LAS float* scr = (LAS float*)(lds + wave * 8704);
    constexpr int I_IN = 16 * 256, I_SQ = 16 * 32, I_PP = 4 * 32, I_GU = 16 * 176, I_FD = 44 * 32;
    constexpr int NITEMS = I_IN + 4 * I_SQ + I_PP + I_GU + I_FD;
    const int lo = late ? I_IN : 0, hi = late ? NITEMS : I_IN;
    for (int it = lo + gw; it < hi; it += NGW) {
        int r = it;
        if (r < I_IN) { const int kb = r >> 8, nb = r & 255; p0_transpose_item<false>(C.w_in, NWIN, 64 * kb, 32 * nb + (32 * nb >= GKCOL ? 16 : 0), C.WIN, D, 32 * nb, scr, lane); continue; } r -= I_IN;
        if (r < 4 * I_SQ) { const int w = r / I_SQ, q = r % I_SQ, kb = q >> 5, nb = q & 31; const float* src = w == 0 ? C.w_a : w == 1 ? C.w_b : w == 2 ? C.w_o : C.w_pg; bf16* dst = w == 0 ? C.WA : w == 1 ? C.WB : w == 2 ? C.WO : C.WPG;
            p0_transpose_item(src, D, 64 * kb, 32 * nb, dst, D, 32 * nb, scr, lane); continue; } r -= 4 * I_SQ;
        if (r < I_PP) { const int kb = r >> 5, nb = r & 31; p0_transpose_item(C.w_pp, D, 64 * kb, 32 * nb, C.WPP, PLE, 32 * nb, scr, lane); continue; } r -= I_PP;
        if (r < I_GU) { const int kb = r / 176, nb = r % 176, tile = nb >> 3, w = nb & 7; p0_transpose_item(w < 4 ? C.w_fg : C.w_fu, FF, 64 * kb, 128 * tile + 32 * (w & 3), C.WGU, D, 32 * nb, scr, lane); continue; } r -= I_GU;
        { const int kb = r >> 5, nb = r & 31; p0_transpose_item(C.w_fd, D, 64 * kb, 32 * nb, C.WD, FF, 32 * nb, scr, lane); }
    }
}
__device__ __forceinline__ void p0_late(const Ctx& C, LAS unsigned char* lds, int tid) {
    p0_items(C, lds, tid, true);
    for (int idx = blockIdx.x * 512 + tid; idx < MP * 32; idx += gridDim.x * 512) {
        const int row = idx >> 5, c8 = (idx & 31) * 8; u32x4 o = (u32x4){0u, 0u, 0u, 0u};
        if (row < MTOK) { const float* src = row < MPROMPT ? C.pp + (size_t)row * PLE + c8 : C.ps + (size_t)(row - MPROMPT) * PLE + c8;
            const f32x4 a = __builtin_nontemporal_load((const f32x4*)src), b = __builtin_nontemporal_load((const f32x4*)(src + 4)); o.x = pk2(a[0], a[1]); o.y = pk2(a[2], a[3]); o.z = pk2(b[0], b[1]); o.w = pk2(b[2], b[3]); }
        __builtin_nontemporal_store(o, (u32x4*)(C.PB + (size_t)row * PLE + c8));
    }
}
__device__ __forceinline__ void p0_prologue(const Ctx& C, LAS unsigned char* lds, int tid) {
    const int wave = tid >> 6, lane = tid & 63, gw = blockIdx.x * 8 + wave, NGW = gridDim.x * 8;
    p0_items(C, lds, tid, false);
    for (int idx = blockIdx.x * 512 + tid; idx < D * 16; idx += gridDim.x * 512) { const int c = idx >> 4, r = idx & 15; C.WGK[r * D + c] = f2bf(C.w_in[(size_t)c * NWIN + GKCOL + r]); }
    f32x4 wp[4];
#pragma unroll
    for (int j = 0; j < 4; ++j) wp[j] = *(const f32x4*)(C.w_pre + 4 * lane + 256 * j);
    for (int m0 = gw; m0 < MTOK; m0 += 4 * NGW) {
        f32x4 v[4][4];
#pragma unroll
        for (int r = 0; r < 4; ++r) { const int m = m0 + r * NGW;
#pragma unroll
            for (int j = 0; j < 4; ++j) { v[r][j] = (f32x4){0.f, 0.f, 0.f, 0.f};
                if (m < MTOK) v[r][j] = __builtin_nontemporal_load((const f32x4*)(m < MPROMPT ? C.xp + (size_t)m * D + 4 * lane + 256 * j : C.xs + (size_t)(m - MPROMPT) * D + 4 * lane + 256 * j)); } }
#pragma unroll
        for (int r = 0; r < 4; ++r) { const int m = m0 + r * NGW; if (m >= MTOK) continue;
            float s = 0.f;
#pragma unroll
            for (int j = 0; j < 4; ++j) s += (v[r][j][0] * v[r][j][0] + v[r][j][1] * v[r][j][1]) + (v[r][j][2] * v[r][j][2] + v[r][j][3] * v[r][j][3]);
            const float rstd = 1.0f / sqrtf(wave_sum(s) * (1.0f / D) + EPS);
#pragma unroll
            for (int j = 0; j < 4; ++j) { const f32x4 o = v[r][j] * rstd * wp[j]; *(u32x2*)(C.X1 + (size_t)m * D + 4 * lane + 256 * j) = (u32x2){pk2(o[0], o[1]), pk2(o[2], o[3])}; } }
    }
}

struct PrepRegs { float wg[16]; float bias; f32x4 gk; bf16 q[16], k[16]; };
__device__ __forceinline__ void prep_load(const Ctx& C, int item, int tid, PrepRegs& R) {
    const int b = item >> 7, h = (item >> 5) & 3, n = item & 31, row0 = b * TSEQ + n * 64, col = tid & 127, rg = tid >> 7;
    R.gk = ((const f32x4*)(C.GKLR + (size_t)row0 * 16))[tid & 255];
#pragma unroll
    for (int r = 0; r < 16; ++r) R.wg[r] = C.w_gk[r * 512 + h * 128 + col];
    R.bias = C.b_gk[h * 128 + col];
    const bf16* zq = C.Z + (size_t)(row0 + rg * 16) * NZ + ZQ + h * 128 + col;
    const bf16* zk = C.Z + (size_t)(row0 + rg * 16) * NZ + ZK + h * 128 + col;
#pragma unroll
    for (int ii = 0; ii < 16; ++ii) { R.q[ii] = __builtin_nontemporal_load(zq + (size_t)ii * NZ); R.k[ii] = __builtin_nontemporal_load(zk + (size_t)ii * NZ); }
}
__device__ __forceinline__ void gla_prep_item(const Ctx& C, int item, LAS unsigned char* lds, int tid, const PrepRegs& R) {
    const int b = item >> 7, h = (item >> 5) & 3, n = item & 31, row0 = b * TSEQ + n * 64;
    LAS float* gkl = (LAS float*)lds;
    LAS float* csum = (LAS float*)(lds + 4096);
    LAS bf16* Qs = (LAS bf16*)(lds + 8192);
    LAS bf16* Ks = (LAS bf16*)(lds + 8192 + 17408);
    const int col = tid & 127, rg = tid >> 7;
    if (tid < 256) ((LAS f32x4*)gkl)[tid] = R.gk;
    const float bias = R.bias;
    __syncthreads();
    float bl[16]; float c = 0.f;
#pragma unroll
    for (int i = 0; i < 16; ++i) { const int row = rg * 16 + i; float g = bias;
#pragma unroll
        for (int r = 0; r < 16; ++r) g += gkl[row * 16 + r] * R.wg[r];
        c += logsig(g) * (1.0f / 16.0f); bl[i] = c; }
    csum[rg * 128 + col] = c;
    __syncthreads();
    const float c0 = csum[col], c1 = csum[128 + col], c2 = csum[256 + col], c3 = csum[384 + col];
    const float off = rg == 0 ? 0.f : rg == 1 ? c0 : rg == 2 ? c0 + c1 : c0 + c1 + c2;
    const float bm = c0 + c1, blast = bm + c2 + c3;
    bf16* qt = C.QT + (size_t)(row0 + rg * 16) * 512 + h * 128 + col;
    const float scale = 0.08838834764831845f;
    unsigned khp[8];
#pragma unroll
    for (int i = 0; i < 16; i += 2) {
        float kh2[2];
#pragma unroll
        for (int e = 0; e < 2; ++e) { const int ii = i + e; const float bb = bl[ii] + off; const float q = bf2f(R.q[ii]) * scale, k = bf2f(R.k[ii]);
            qt[(size_t)ii * 512] = f2bf(q * __expf(bb));
            Qs[(rg * 16 + ii) * 136 + col] = f2bf(q * __expf(bb - bm)); Ks[(rg * 16 + ii) * 136 + col] = f2bf(k * __expf(bm - bb));
            kh2[e] = k * __expf(blast - bb); }
        khp[i >> 1] = pk2(kh2[0], kh2[1]);
    }
    { bf16* dst = C.KHT + ((size_t)item * 128 + col) * 64 + rg * 16;
      *(u32x4*)dst = (u32x4){khp[0], khp[1], khp[2], khp[3]}; *(u32x4*)(dst + 8) = (u32x4){khp[4], khp[5], khp[6], khp[7]}; }
    if (rg == 0) C.DBUF[(size_t)item * 128 + col] = __expf(blast);
    __syncthreads();
    const int wave = tid >> 6, lane = tid & 63, l15 = lane & 15, quad = lane >> 4, tr = wave >> 1;
#pragma unroll
    for (int cc = 0; cc < 2; ++cc) { const int tc = (wave & 1) * 2 + cc; u32x2 ow = (u32x2){0u, 0u};
        const int t = tr * 16 + l15, s0 = tc * 16 + quad * 4;
        if (tc <= tr) { f32x4 acc = (f32x4){0.f, 0.f, 0.f, 0.f};
#pragma unroll
            for (int kk = 0; kk < 4; ++kk) { const bf16x8 a = *(const LAS bf16x8*)(Ks + (tc * 16 + l15) * 136 + kk * 32 + quad * 8), bq = *(const LAS bf16x8*)(Qs + (tr * 16 + l15) * 136 + kk * 32 + quad * 8);
                acc = __builtin_amdgcn_mfma_f32_16x16x32_bf16(a, bq, acc, 0, 0, 0); }
#pragma unroll
            for (int j = 0; j < 4; ++j) if (s0 + j > t) acc[j] = 0.f;
            ow.x = pk2(acc[0], acc[1]); ow.y = pk2(acc[2], acc[3]); }
        *(u32x2*)(C.SC + ((size_t)item * 64 + t) * 64 + s0) = ow; }
    __syncthreads();
}
__device__ __forceinline__ void gla_sample_item(const Ctx& C, int item, LAS unsigned char* lds, int tid) {
    const int s = item >> 2, h = item & 3, m = MPROMPT + s, wave = tid >> 6, lane = tid & 63;
    LAS float* av = (LAS float*)lds; LAS float* qs = av + 128; LAS float* kk = av + 256; LAS float* vv = av + 384; LAS float* part = (LAS float*)(lds + 4096);
    const bf16* zr = C.Z + (size_t)m * NZ;
    if (tid < 128) { float g = C.b_gk[h * 128 + tid];
#pragma unroll
        for (int r = 0; r < 16; ++r) g += C.GKLR[(size_t)m * 16 + r] * C.w_gk[r * 512 + h * 128 + tid];
        av[tid] = __expf(logsig(g) * (1.0f / 16.0f)); qs[tid] = bf2f(zr[ZQ + h * 128 + tid]) * 0.08838834764831845f; kk[tid] = bf2f(zr[ZK + h * 128 + tid]); }
    else if (tid < 384) vv[tid - 128] = bf2f(zr[ZV + h * 256 + tid - 128]);
    __syncthreads();
    const f32x4 v4 = ((const LAS f32x4*)vv)[lane]; f32x4 o = (f32x4){0.f, 0.f, 0.f, 0.f};
    const f32x4* S0 = (const f32x4*)(C.st_gla + (size_t)item * 128 * 256); f32x4* So = (f32x4*)(C.out + OUT_GLAS + (size_t)item * 128 * 256);
    f32x4 s0v[16];
#pragma unroll
    for (int it = 0; it < 16; ++it) s0v[it] = __builtin_nontemporal_load(S0 + (it * 8 + wave) * 64 + lane);
#pragma unroll
    for (int it = 0; it < 16; ++it) { const int k = it * 8 + wave; const f32x4 s0 = s0v[it]; const f32x4 sn = s0 * av[k] + v4 * kk[k]; __builtin_nontemporal_store(sn, So + k * 64 + lane); o += sn * qs[k]; }
    ((LAS f32x4*)(part + wave * 256))[lane] = o;
    __syncthreads();
    if (wave == 0) { f32x4 t = (f32x4){0.f, 0.f, 0.f, 0.f};
#pragma unroll
        for (int w = 0; w < 8; ++w) t += ((const LAS f32x4*)(part + w * 256))[lane];
        const float ss = wave_sum((t[0] * t[0] + t[1] * t[1]) + (t[2] * t[2] + t[3] * t[3]));
        const float rstd = 1.0f / sqrtf(ss * (1.0f / 256.0f) + EPS);
        const f32x4 wn = *(const f32x4*)(C.w_gn + 4 * lane); const u32x2 gw = *(const u32x2*)(zr + ZG + h * 256 + 4 * lane);
        const float g0 = bf_lo(gw.x), g1 = bf_hi(gw.x), g2 = bf_lo(gw.y), g3 = bf_hi(gw.y);
        *(u32x2*)(C.X3 + (size_t)m * D + h * 256 + 4 * lane) = (u32x2){pk2(t[0] * rstd * wn[0] * siluf(g0), t[1] * rstd * wn[1] * siluf(g1)), pk2(t[2] * rstd * wn[2] * siluf(g2), t[3] * rstd * wn[3] * siluf(g3))}; }
    __syncthreads();
}
__device__ __forceinline__ void conv_phase(const Ctx& C, int tid) {
    for (int idx = blockIdx.x * 512 + tid; idx < 1024 * 128; idx += gridDim.x * 512) {
        const int c8 = (idx & 127) * 8, seg = idx >> 7, m0 = seg * 16, tpos0 = m0 & (TSEQ - 1);
        float w0[8], w1[8], w2[8], u1[8], u2[8];
#pragma unroll
        for (int e = 0; e < 8; ++e) { w0[e] = C.w_conv[c8 + e]; w1[e] = C.w_conv[D + c8 + e]; w2[e] = C.w_conv[2 * D + c8 + e]; u1[e] = 0.f; u2[e] = 0.f; }
        if (tpos0 != 0) { float ca[8], xa[8]; const bf16* zr = C.Z + (size_t)(m0 - 1) * NZ;
            unpack8(*(const u32x4*)(zr + ZC + c8), ca); unpack8(*(const u32x4*)(zr + ZX + c8), xa);
#pragma unroll
            for (int e = 0; e < 8; ++e) u1[e] = ca[e] * xa[e];
            unpack8(*(const u32x4*)(zr - NZ + ZC + c8), ca); unpack8(*(const u32x4*)(zr - NZ + ZX + c8), xa);
#pragma unroll
            for (int e = 0; e < 8; ++e) u2[e] = ca[e] * xa[e]; }
#pragma unroll
        for (int rr = 0; rr < 16; rr += 4) {
            u32x4 vb[4], vc[4], vx[4];
#pragma unroll
            for (int i = 0; i < 4; ++i) { const bf16* zr = C.Z + (size_t)(m0 + rr + i) * NZ; vb[i] = __builtin_nontemporal_load((const u32x4*)(zr + ZB + c8)); vc[i] = __builtin_nontemporal_load((const u32x4*)(zr + ZC + c8)); vx[i] = __builtin_nontemporal_load((const u32x4*)(zr + ZX + c8)); }
#pragma unroll
            for (int i = 0; i < 4; ++i) { const int m = m0 + rr + i, tpos = tpos0 + rr + i; float ba[8], ca[8], xa[8], o[8], u0[8];
                unpack8(vb[i], ba); unpack8(vc[i], ca); unpack8(vx[i], xa);
#pragma unroll
                for (int e = 0; e < 8; ++e) { u0[e] = ca[e] * xa[e]; o[e] = ba[e] * (w0[e] * u2[e] + w1[e] * u1[e] + w2[e] * u0[e]); u2[e] = u1[e]; u1[e] = u0[e]; }
                __builtin_nontemporal_store(pack8(o), (u32x4*)(C.X2 + (size_t)m * D + c8));
                if (tpos >= TSEQ - 2) { float* dst = C.out + OUT_CONVP + ((size_t)(m >> 11) * 2 + (tpos - (TSEQ - 2))) * D + c8;
                    *(f32x4*)dst = (f32x4){u0[0], u0[1], u0[2], u0[3]}; *(f32x4*)(dst + 4) = (f32x4){u0[4], u0[5], u0[6], u0[7]}; } }
        }
    }
    for (int idx = blockIdx.x * 512 + tid; idx < NSAMP * 128; idx += gridDim.x * 512) {
        const int s = idx >> 7, c8 = (idx & 127) * 8, m = MPROMPT + s;
        const bf16* zr = C.Z + (size_t)m * NZ;
        float ba[8], ca[8], xa[8], o[8];
        unpack8(*(const u32x4*)(zr + ZB + c8), ba); unpack8(*(const u32x4*)(zr + ZC + c8), ca); unpack8(*(const u32x4*)(zr + ZX + c8), xa);
        const float* b0 = C.st_conv + ((size_t)s * 2 + 0) * D + c8; const float* b1 = b0 + D;
        float* d0 = C.out + OUT_CONVS + ((size_t)s * 2 + 0) * D + c8; float* d1 = d0 + D;
#pragma unroll
        for (int e = 0; e < 8; ++e) { const float u0 = ca[e] * xa[e], p0 = b0[e], p1 = b1[e];
            o[e] = ba[e] * (C.w_conv[c8 + e] * p0 + C.w_conv[D + c8 + e] * p1 + C.w_conv[2 * D + c8 + e] * u0); d0[e] = p1; d1[e] = u0; }
        *(u32x4*)(C.X2 + (size_t)m * D + c8) = pack8(o);
    }
}

__device__ __forceinline__ void gla_scan_item(const Ctx& C, int item, LAS unsigned char* lds, int tid) {
    const int jx = item >> 3, bh = (item & 7) * 4 + (jx >> 3), sl = jx & 7, b = bh >> 2, h = bh & 3;
    LAS bf16* Aq = (LAS bf16*)lds;
    LAS bf16* Bc = (LAS bf16*)(lds + 25600);
    LAS bf16* Kt = (LAS bf16*)(lds + 38400);
    const int wave = tid >> 6, lane = tid & 63, l15 = lane & 15, quad = lane >> 4;
    f32x4 S[2] = {(f32x4){0.f, 0.f, 0.f, 0.f}, (f32x4){0.f, 0.f, 0.f, 0.f}};
    *(LAS u32x4*)(Bc + (tid >> 4) * 200 + (tid & 15) * 8) = (u32x4){0u, 0u, 0u, 0u};
    u32x4 rq0A, rq1A, rsA, rk0A, rk1A, rvA = (u32x4){0u, 0u, 0u, 0u}; f32x4 rdA;
    u32x4 rq0B, rq1B, rsB, rk0B, rk1B, rvB = (u32x4){0u, 0u, 0u, 0u}; f32x4 rdB;
#define SCAN_LOAD(X, n) do { const size_t itn = (size_t)bh * 32 + (n); const size_t r0 = (size_t)b * TSEQ + (size_t)(n) * 64; \
        rq0##X = *(const u32x4*)(C.QT + (r0 + (tid >> 4)) * 512 + h * 128 + (tid & 15) * 8); rq1##X = *(const u32x4*)(C.QT + (r0 + 32 + (tid >> 4)) * 512 + h * 128 + (tid & 15) * 8); \
        rs##X = *(const u32x4*)(C.SC + (itn * 64 + (tid >> 3)) * 64 + (tid & 7) * 8); \
        rk0##X = *(const u32x4*)(C.KHT + (itn * 128 + (tid >> 3)) * 64 + (tid & 7) * 8); rk1##X = *(const u32x4*)(C.KHT + (itn * 128 + 64 + (tid >> 3)) * 64 + (tid & 7) * 8); \
        rv##X = *(const u32x4*)(C.Z + (r0 + ((tid & 255) >> 2)) * NZ + ZV + h * 256 + sl * 32 + (tid & 3) * 8); \
        rd##X = *(const f32x4*)(C.DBUF + itn * 128 + wave * 16 + quad * 4); } while (0)
#define SCAN_STEP(X, n) do { \
        *(LAS u32x4*)(Aq + (tid >> 4) * 200 + (tid & 15) * 8) = rq0##X; *(LAS u32x4*)(Aq + (32 + (tid >> 4)) * 200 + (tid & 15) * 8) = rq1##X; \
        *(LAS u32x4*)(Aq + (tid >> 3) * 200 + 128 + (tid & 7) * 8) = rs##X; \
        *(LAS u32x4*)(Kt + (tid >> 3) * 72 + (tid & 7) * 8) = rk0##X; *(LAS u32x4*)(Kt + (64 + (tid >> 3)) * 72 + (tid & 7) * 8) = rk1##X; \
        if (tid < 256) { const int t = tid >> 2, c = (tid & 3) * 8; LAS bf16* d = Bc + c * 200 + 128 + t; \
            d[0] = (bf16)(rv##X.x & 0xffffu); d[200] = (bf16)(rv##X.x >> 16); d[400] = (bf16)(rv##X.y & 0xffffu); d[600] = (bf16)(rv##X.y >> 16); \
            d[800] = (bf16)(rv##X.z & 0xffffu); d[1000] = (bf16)(rv##X.z >> 16); d[1200] = (bf16)(rv##X.w & 0xffffu); d[1400] = (bf16)(rv##X.w >> 16); } \
        const f32x4 dcur = rd##X; \
        const size_t tok0 = (size_t)b * TSEQ + (size_t)(n) * 64; \
        if ((n) + 2 < 32) SCAN_LOAD(X, (n) + 2); \
        __syncthreads(); \
        { const int vt = wave & 1, tt = wave >> 1; f32x4 acc = (f32x4){0.f, 0.f, 0.f, 0.f}; \
          _Pragma("unroll") for (int kk = 0; kk < 6; ++kk) { const bf16x8 a = *(const LAS bf16x8*)(Bc + (vt * 16 + l15) * 200 + kk * 32 + quad * 8), bq = *(const LAS bf16x8*)(Aq + (tt * 16 + l15) * 200 + kk * 32 + quad * 8); \
              acc = __builtin_amdgcn_mfma_f32_16x16x32_bf16(a, bq, acc, 0, 0, 0); } \
          *(u32x2*)(C.X4 + (tok0 + tt * 16 + l15) * D + h * 256 + sl * 32 + vt * 16 + quad * 4) = (u32x2){pk2(acc[0], acc[1]), pk2(acc[2], acc[3])}; } \
        _Pragma("unroll") for (int v2 = 0; v2 < 2; ++v2) { S[v2] = S[v2] * dcur; \
            _Pragma("unroll") for (int kk = 0; kk < 2; ++kk) { const bf16x8 a = *(const LAS bf16x8*)(Kt + (wave * 16 + l15) * 72 + kk * 32 + quad * 8), bq = *(const LAS bf16x8*)(Bc + (v2 * 16 + l15) * 200 + 128 + kk * 32 + quad * 8); \
                S[v2] = __builtin_amdgcn_mfma_f32_16x16x32_bf16(a, bq, S[v2], 0, 0, 0); } } \
        __syncthreads(); \
        _Pragma("unroll") for (int v2 = 0; v2 < 2; ++v2) *(LAS u32x2*)(Bc + (v2 * 16 + l15) * 200 + wave * 16 + quad * 4) = (u32x2){pk2(S[v2][0], S[v2][1]), pk2(S[v2][2], S[v2][3])}; \
    } while (0)
    SCAN_LOAD(A, 0); SCAN_LOAD(B, 1);
#pragma unroll
    for (int n = 0; n < 32; n += 2) { SCAN_STEP(A, n); SCAN_STEP(B, n + 1); }
#undef SCAN_STEP
#undef SCAN_LOAD
    float* So = C.out + OUT_GLAP + ((size_t)bh * 128 + wave * 16 + quad * 4) * 256 + sl * 32 + l15;
#pragma unroll
    for (int v2 = 0; v2 < 2; ++v2)
#pragma unroll
        for (int j = 0; j < 4; ++j) So[(size_t)j * 256 + v2 * 16] = S[v2][j];
    __syncthreads();
}

__device__ __forceinline__ void p4_onorm(const Ctx& C, int tid) {
    const int wave = tid >> 6, lane = tid & 63, gw = blockIdx.x * 8 + wave, NGW = gridDim.x * 8;
    const f32x4 wn = *(const f32x4*)(C.w_gn + 4 * lane);
    for (int m0 = gw; m0 < MPROMPT; m0 += 4 * NGW) {
        u32x2 ov[4][4], gv[4][4];
#pragma unroll
        for (int r = 0; r < 4; ++r) { const int m = m0 + r * NGW;
#pragma unroll
            for (int j = 0; j < 4; ++j) { ov[r][j] = (u32x2){0u, 0u}; gv[r][j] = (u32x2){0u, 0u};
                if (m < MPROMPT) { ov[r][j] = __builtin_nontemporal_load((const u32x2*)(C.X4 + (size_t)m * D + 4 * lane + 256 * j)); gv[r][j] = __builtin_nontemporal_load((const u32x2*)(C.Z + (size_t)m * NZ + ZG + 4 * lane + 256 * j)); } } }
#pragma unroll
        for (int r = 0; r < 4; ++r) { const int m = m0 + r * NGW; if (m >= MPROMPT) continue;
#pragma unroll
            for (int j = 0; j < 4; ++j) { const u32x2 ow = ov[r][j], gw2 = gv[r][j];
                const float o0 = bf_lo(ow.x), o1 = bf_hi(ow.x), o2 = bf_lo(ow.y), o3 = bf_hi(ow.y);
                const float rstd = 1.0f / sqrtf(wave_sum((o0 * o0 + o1 * o1) + (o2 * o2 + o3 * o3)) * (1.0f / 256.0f) + EPS);
                *(u32x2*)(C.X3 + (size_t)m * D + 4 * lane + 256 * j) = (u32x2){pk2(o0 * rstd * wn[0] * siluf(bf_lo(gw2.x)), o1 * rstd * wn[1] * siluf(bf_hi(gw2.x))), pk2(o2 * rstd * wn[2] * siluf(bf_lo(gw2.y)), o3 * rstd * wn[3] * siluf(bf_hi(gw2.y)))}; } }
    }
}
template <int MODE> __device__ __forceinline__ void ew_rows(const Ctx& C, int tid) {
    const int wave = tid >> 6, lane = tid & 63, gw = blockIdx.x * 8 + wave, NGW = gridDim.x * 8;
    const float* wsc = MODE == 0 ? C.w_post : MODE == 1 ? C.w_fpost : C.w_ppost;
    const bf16* baseb = MODE == 1 ? C.HB : C.X1;
    f32x4 wv[4], wf[4];
#pragma unroll
    for (int j = 0; j < 4; ++j) { wv[j] = *(const f32x4*)(wsc + 4 * lane + 256 * j); wf[j] = MODE == 0 ? *(const f32x4*)(C.w_fpre + 4 * lane + 256 * j) : (f32x4){1.f, 1.f, 1.f, 1.f}; }
    const float* PARTS = C.PART + (WS_PARTS - WS_PART) / 4;
    float pA[2], pB[2]; u32x2 svA[2][4], svB[2][4], bbA[2][4], bbB[2][4]; f32x4 bvA[2][4], bvB[2][4];
#define EW_LOAD(X, g) do { _Pragma("unroll") for (int r = 0; r < 2; ++r) { const int m_ = gwx + NGW * (2 * (g) + r), m = m_ < MTOK ? m_ : MTOK - 1; \
            const float* pp = m >= MPROMPT ? PARTS + (size_t)lane * NSAMP + (m - MPROMPT) : C.PART + (size_t)(lane & 15) * MP + m; \
            const float pv = *pp; p##X[r] = (m < MPROMPT && lane >= 16) ? 0.f : pv; \
            const float* bp = m < MPROMPT ? C.xp + (size_t)m * D : C.xs + (size_t)(m - MPROMPT) * D; \
            _Pragma("unroll") for (int j = 0; j < 4; ++j) { const int c = 4 * lane + 256 * j; sv##X[r][j] = __builtin_nontemporal_load((const u32x2*)(C.X2 + (size_t)m * D + c)); \
                if (MODE == 0) bv##X[r][j] = __builtin_nontemporal_load((const f32x4*)(bp + c)); else bb##X[r][j] = __builtin_nontemporal_load((const u32x2*)(baseb + (size_t)m * D + c)); } } } while (0)
#define EW_COMP(X, g) do { _Pragma("unroll") for (int r = 0; r < 2; ++r) { const int m = gwx + NGW * (2 * (g) + r); \
            const float rs = 1.0f / sqrtf(wave_sum(p##X[r]) * (1.0f / D) + EPS); f32x4 hv[4]; float s = 0.f; \
            _Pragma("unroll") for (int j = 0; j < 4; ++j) { const u32x2 w = sv##X[r][j]; const f32x4 t = (f32x4){bf_lo(w.x), bf_hi(w.x), bf_lo(w.y), bf_hi(w.y)}; \
                f32x4 bs; if (MODE == 0) bs = bv##X[r][j]; else { const u32x2 bw = bb##X[r][j]; bs = (f32x4){bf_lo(bw.x), bf_hi(bw.x), bf_lo(bw.y), bf_hi(bw.y)}; } \
                hv[j] = bs + t * rs * wv[j]; s += (hv[j][0] * hv[j][0] + hv[j][1] * hv[j][1]) + (hv[j][2] * hv[j][2] + hv[j][3] * hv[j][3]); } \
            float rstd = 1.0f; if (MODE == 0) rstd = 1.0f / sqrtf(wave_sum(s) * (1.0f / D) + EPS); \
            if (m < MTOK) { _Pragma("unroll") for (int j = 0; j < 4; ++j) { const int c = 4 * lane + 256 * j; \
                if (MODE == 2) __builtin_nontemporal_store(hv[j], (f32x4*)(C.out + OUT_Y + (size_t)m * D + c)); \
                else { if (MODE == 0) __builtin_nontemporal_store((u32x2){pk2(hv[j][0], hv[j][1]), pk2(hv[j][2], hv[j][3])}, (u32x2*)(C.HB + (size_t)m * D + c)); \
                    const f32x4 o = hv[j] * rstd * wf[j]; *(u32x2*)(C.X1 + (size_t)m * D + c) = (u32x2){pk2(o[0], o[1]), pk2(o[2], o[3])}; } } } } } while (0)
    for (int gwx = gw; gwx < MTOK; gwx += 10 * NGW) {
    EW_LOAD(A, 0); EW_LOAD(B, 1); EW_COMP(A, 0); EW_LOAD(A, 2); EW_COMP(B, 1); EW_LOAD(B, 3); EW_COMP(A, 2); EW_LOAD(A, 4); EW_COMP(B, 3); EW_COMP(A, 4);
    }
#undef EW_LOAD
#undef EW_COMP
}

#define XB_TMO      128
#define XB_XCNT(j)  (256  + 64 * (j))
#define XB_XSUB(j)  (1280 + 64 * (j))
#define XB_XGEN(j)  (2304 + 64 * (j))
#define XB_TOP      3328
#define XB_TOPGEN   3392
#define XCD_BAR_WORDS 3456
#define XB_SPIN_CAP (1u << 18)

__device__ __forceinline__ unsigned xb_ld(unsigned* p)              { return __hip_atomic_load(p, __ATOMIC_RELAXED, __HIP_MEMORY_SCOPE_AGENT); }
__device__ __forceinline__ unsigned xb_add(unsigned* p, unsigned v) { return __hip_atomic_fetch_add(p, v, __ATOMIC_RELAXED, __HIP_MEMORY_SCOPE_AGENT); }
__device__ __forceinline__ unsigned xb_xcc_id() { return (unsigned)__builtin_amdgcn_s_getreg((3 << 11) | 20) & 0xFu; }
#define XB_SPIN(cond, bar) do { unsigned _sp = 0; while (cond) { __builtin_amdgcn_s_sleep(1); \
    if ((++_sp & 255u) == 0u) { if (xb_ld(&(bar)[XB_TMO])) break; if (_sp > XB_SPIN_CAP) { atomicAdd(&(bar)[XB_TMO], 1u); break; } } } } while (0)

struct XcdBarrier {
    unsigned* bar; unsigned x;
    volatile LAS unsigned* st;
};

__device__ __forceinline__ XcdBarrier xcd_barrier_post(unsigned* bar, volatile LAS unsigned* st) {
    XcdBarrier b; b.bar = bar; b.x = xb_xcc_id(); b.st = st;
    if (threadIdx.x == 0) (void)xb_add(&bar[XB_XCNT(b.x)], 1u);
    return b;
}
__device__ __forceinline__ void xcd_barrier_complete(unsigned* bar, unsigned x, unsigned& nloc, unsigned& nx) {
    const unsigned G = gridDim.x * gridDim.y * gridDim.z;
    unsigned sum, cnt, mine, sp = 0u;
    for (;;) {
        sum = 0u; cnt = 0u; mine = 0u;
#pragma unroll
        for (unsigned j = 0; j < 16; ++j) { const unsigned c = xb_ld(&bar[XB_XCNT(j)]); sum += c; cnt += (c > 0u) ? 1u : 0u; mine = (j == x) ? c : mine; }
        if (sum == G) break;
        __builtin_amdgcn_s_sleep(1);
        if ((++sp & 255u) == 0u) { if (xb_ld(&bar[XB_TMO])) break; if (sp > XB_SPIN_CAP) { atomicAdd(&bar[XB_TMO], 1u); break; } }
    }
    nloc = mine > 0u ? mine : 1u; nx = cnt > 0u ? cnt : 1u;
}

__device__ __forceinline__ void xcd_barrier(const XcdBarrier& b) {
    asm volatile("s_waitcnt vmcnt(0)" ::: "memory");
    __syncthreads();
    if (threadIdx.x == 0) {
        unsigned* bar = b.bar;
        __builtin_amdgcn_s_waitcnt(0);
        unsigned nloc = b.st[0], nx = b.st[1];
        if (nloc == 0u) { xcd_barrier_complete(bar, b.x, nloc, nx); b.st[0] = nloc; b.st[1] = nx; }
        const unsigned old = xb_add(&bar[XB_XSUB(b.x)], 1u);
        const unsigned gen = old / nloc;
        if (old + 1u == (gen + 1u) * nloc) {
            __builtin_amdgcn_fence(__ATOMIC_RELEASE, "agent");
            asm volatile("s_waitcnt vmcnt(0)" ::: "memory");
            const unsigned og = xb_add(&bar[XB_TOP], 1u);
            const unsigned tg = og / nx;
            if (og + 1u == (tg + 1u) * nx) xb_add(&bar[XB_TOPGEN], 1u);
            else XB_SPIN(xb_ld(&bar[XB_TOPGEN]) == tg, bar);
            __builtin_amdgcn_fence(__ATOMIC_ACQUIRE, "agent");
            xb_add(&bar[XB_XGEN(b.x)], 1u);
            asm volatile("s_waitcnt vmcnt(0)" ::: "memory");
        } else {
            XB_SPIN(xb_ld(&bar[XB_XGEN(b.x)]) == gen, bar);
            __builtin_amdgcn_fence(__ATOMIC_ACQUIRE, "agent");
            asm volatile("s_waitcnt vmcnt(0)" ::: "memory");
        }
    }
    __syncthreads();
}


constexpr int NPHASE = 13;
__global__ void __launch_bounds__(512, 2) fwd_mega(Args a) {
    extern __shared__ __attribute__((aligned(16))) unsigned char lds_raw[];
    LAS unsigned char* lds = (LAS unsigned char*)lds_raw;
    const int tid = threadIdx.x, G = gridDim.x, bx = blockIdx.x;
    Ctx C;
    C.xp = a.in[0]; C.xs = a.in[1]; C.st_conv = a.in[2]; C.st_gla = a.in[3]; C.pp = a.in[4]; C.ps = a.in[5]; C.w_pre = a.in[6]; C.w_in = a.in[7]; C.w_conv = a.in[8]; C.w_a = a.in[9];
    C.w_gk = a.in[10]; C.b_gk = a.in[11]; C.w_gn = a.in[12]; C.w_b = a.in[13]; C.w_o = a.in[14]; C.w_post = a.in[15]; C.w_fpre = a.in[16]; C.w_fg = a.in[17]; C.w_fu = a.in[18]; C.w_fd = a.in[19];
    C.w_fpost = a.in[20]; C.w_pp = a.in[21]; C.w_pg = a.in[22]; C.w_ppost = a.in[23]; C.out = a.out;
    unsigned char* ws = a.ws;
    C.WIN = (bf16*)(ws + WS_WIN); C.WA = (bf16*)(ws + WS_WA); C.WB = (bf16*)(ws + WS_WB); C.WO = (bf16*)(ws + WS_WO); C.WPG = (bf16*)(ws + WS_WPG); C.WPP = (bf16*)(ws + WS_WPP);
    C.WGU = (bf16*)(ws + WS_WGU); C.WD = (bf16*)(ws + WS_WD); C.PB = (bf16*)(ws + WS_PB); C.X1 = (bf16*)(ws + WS_X1); C.X2 = (bf16*)(ws + WS_X2); C.X3 = (bf16*)(ws + WS_X3); C.X4 = (bf16*)(ws + WS_X4);
    C.Z = (bf16*)(ws + WS_Z); C.HID = (bf16*)(ws + WS_HID); C.KHT = (bf16*)(ws + WS_KHT); C.SC = (bf16*)(ws + WS_SC);
    C.GKLR = (float*)(ws + WS_GKLR); C.PART = (float*)(ws + WS_PART); C.DBUF = (float*)(ws + WS_DBUF); C.HB = (bf16*)(ws + WS_H); C.QT = (bf16*)(ws + WS_QT); C.WGK = (bf16*)(ws + WS_WGK);
    const int lo = a.ph_lo, hi = a.ph_hi;
#define IN(k) (lo <= (k) && (k) < hi)
    if (tid < 4) ((LAS unsigned*)(lds + LDS_BARST))[tid] = 0u;
    __syncthreads();
    const XcdBarrier bar = xcd_barrier_post((unsigned*)(ws + WS_CTL), (volatile LAS unsigned*)(lds + LDS_BARST));
    if (lo == 0x7fffffff) cg::this_grid().sync();
#define SEAM(k) do { if (IN(k) && IN((k) + 1)) xcd_barrier(bar); } while (0)
#define GEMM(EPI, Aptr, Bptr, Mv, Nv, Kv, Eobj) do { pg8::Gemm g{(const pg8::bf16_t*)(Aptr), (const pg8::bf16_t*)(Bptr), Mv, Nv, Kv}; pg8::StaticOrder S; S.init(Mv, Nv, G, bx); \
        pg8::gemm_phase<EPI, pg8::StaticOrder, true, true>(lds, g, S, Eobj); } while (0)

    if (IN(0)) for (int r_ = 0; r_ < REP[0]; ++r_) { p0_prologue(C, lds, tid); } SEAM(0);
    const size_t SR = (size_t)MPROMPT;
    float* PARTS = (float*)(ws + WS_PARTS);
    if (IN(1)) { const bool late_first = (bx >> 3) & 1;
        if (late_first) { int t_ = tid; asm volatile("" : "+v"(t_)); p0_late(C, lds, t_); __syncthreads(); }
        { EpiStore E{C.Z, NZ}; GEMM(EpiStore, C.X1, C.WIN, MPROMPT, NZ, D, E); }
        { MiniStore E{C.Z, NZ}; mini_gemm<false>(C.X1, MPROMPT, 1, C.WIN, D, NZ / 16, 0, E, lds, tid); }
        { MiniF32 E{C.GKLR, 16}; mini_gemm<false>(C.X1, 0, MTOK / 128, C.WGK, D, 1, 64, E, lds, tid); }
        if (!late_first) { int t_ = tid; asm volatile("" : "+v"(t_)); p0_late(C, lds, t_); } } SEAM(1);
    if (IN(2)) for (int r_ = 0; r_ < REP[2]; ++r_) {
        if ((bx >> 3) & 1) { conv_phase(C, tid); for (int it = bx; it < NSAMP * 4; it += G) gla_sample_item(C, it, lds, tid); }
        { PrepRegs Rn; if (bx < 1024) prep_load(C, bx, tid, Rn);
          for (int it = bx; it < 1024; it += G) { const PrepRegs Rc = Rn; if (it + G < 1024) prep_load(C, it + G, tid, Rn); gla_prep_item(C, it, lds, tid, Rc); } }
        if (!((bx >> 3) & 1)) { for (int it = bx; it < NSAMP * 4; it += G) gla_sample_item(C, it, lds, tid); conv_phase(C, tid); }
    } SEAM(2);
    if (IN(3)) for (int r_ = 0; r_ < REP[3]; ++r_) { for (int it = bx; it < 256; it += G) gla_scan_item(C, it, lds, tid); } SEAM(3);
    if (IN(4)) { const bool gemm_first = !((bx >> 3) & 1);
        if (!gemm_first) { int t_ = tid; asm volatile("" : "+v"(t_)); p4_onorm(C, t_); }
        { EpiGate<false> E{C.Z + ZGA, nullptr, C.X1}; GEMM(EpiGate<false>, C.X2, C.WA, MPROMPT, D, D, E); }
        if (gemm_first) { int t_ = tid; asm volatile("" : "+v"(t_)); p4_onorm(C, t_); } } SEAM(4);
    if (IN(5)) for (int r_ = 0; r_ < REP[5]; ++r_) {
        { EpiGate<true> E{C.Z + ZGB, C.X1, C.X1}; GEMM(EpiGate<true>, C.X3, C.WB, MPROMPT, D, D, E); }
        { MiniGate<false> E{C.Z + ZGA, nullptr, C.X1}; mini_gemm<false, 2>(C.X2, MPROMPT, 1, C.WA, D, D / 16, 0, E, lds, tid); }
        { MiniGate<true> E{C.Z + ZGB, C.X1, C.X1}; mini_gemm<false, 2>(C.X3, MPROMPT, 1, C.WB, D, D / 16, 0, E, lds, tid); }
    } SEAM(5);
    if (IN(6)) for (int r_ = 0; r_ < REP[6]; ++r_) { { EpiSq<false> E{C.X2, nullptr, C.PART}; GEMM(EpiSq<false>, C.X1, C.WO, MPROMPT, D, D, E); }
        { MiniSq<false> E{C.X2, nullptr, PARTS}; mini_gemm<false, 2>(C.X1, MPROMPT, 1, C.WO, D, D / 16, 0, E, lds, tid); } } SEAM(6);
    if (IN(7)) for (int r_ = 0; r_ < REP[7]; ++r_) { ew_rows<0>(C, tid); } SEAM(7);
    if (IN(8)) for (int r_ = 0; r_ < REP[8]; ++r_) { { EpiSwiGLU E{C.HID}; GEMM(EpiSwiGLU, C.X1, C.WGU, MPROMPT, 2 * FF, D, E); }
        { MiniSwiGLU E{C.HID}; mini_gemm<true>(C.X1, MPROMPT, 1, C.WGU, D, FF / 16, G / 2, E, lds, tid); }
        { EpiStore E{C.X3, D}; pg8::Gemm g{(const pg8::bf16_t*)C.PB, (const pg8::bf16_t*)C.WPP, MPROMPT, D, PLE}; pg8::StaticOrder S;
          const int hG = G / 2; S.init(MPROMPT, D, G >= 2 ? hG : 1, G >= 2 ? (bx >= hG ? bx - hG : 0x3fffffff) : 0);
          pg8::gemm_phase<EpiStore, pg8::StaticOrder, true, true>(lds, g, S, E); } } SEAM(8);
    if (IN(9)) for (int r_ = 0; r_ < REP[9]; ++r_) { { EpiSq<false> E{C.X2, nullptr, C.PART}; GEMM(EpiSq<false>, C.HID, C.WD, MPROMPT, D, FF, E); }
        { MiniSq<false> E{C.X2, nullptr, PARTS}; mini_gemm<false, 2>(C.HID, MPROMPT, 1, C.WD, FF, D / 16, 0, E, lds, tid); } } SEAM(9);
    if (IN(10)) for (int r_ = 0; r_ < REP[10]; ++r_) { ew_rows<1>(C, tid); } SEAM(10);
    if (IN(11)) for (int r_ = 0; r_ < REP[11]; ++r_) {
        { EpiSq<true> E{C.X2, C.X3, C.PART}; GEMM(EpiSq<true>, C.X1, C.WPG, MPROMPT, D, D, E); }
        { MiniStore E{C.X3, D}; mini_gemm<false, 2>(C.PB, MPROMPT, 1, C.WPP, PLE, D / 16, 0, E, lds, tid); }
        { MiniSq<true> E{C.X2, C.X3, PARTS}; mini_gemm<false, 2>(C.X1, MPROMPT, 1, C.WPG, D, D / 16, 0, E, lds, tid); }
    } SEAM(11);
    if (IN(12)) for (int r_ = 0; r_ < REP[12]; ++r_) { ew_rows<2>(C, tid); }
}

extern "C" void kernel_launch(void* const* d_in, const int* in_sizes, int n_in, void* d_out, int out_size, void* d_ws, size_t ws_size, hipStream_t stream) {
    static int grid = 0;
    if (grid == 0) {
        int dev = 0, cus = 0, per_cu = 0;
        hipGetDevice(&dev); hipDeviceGetAttribute(&cus, hipDeviceAttributeMultiprocessorCount, dev);
        if (hipFuncSetAttribute((const void*)fwd_mega, hipFuncAttributeMaxDynamicSharedMemorySize, LDS_BYTES) != hipSuccess) { fprintf(stderr, "hipFuncSetAttribute failed\n"); }
        if (hipOccupancyMaxActiveBlocksPerMultiprocessor(&per_cu, (const void*)fwd_mega, 512, LDS_BYTES) != hipSuccess || per_cu < 1) { fprintf(stderr, "occupancy query: %d\n", per_cu); per_cu = 1; }
        (void)hipGetLastError();
        grid = cus * (per_cu > 1 ? 1 : per_cu);
        if (ws_size < WS_END) fprintf(stderr, "workspace too small: %zu < %zu\n", ws_size, (size_t)WS_END);
    }
    (void)hipMemsetAsync((char*)d_ws + WS_CTL, 0, CTL_BYTES, stream);
    Args a{};
    for (int i = 0; i < 24; ++i) a.in[i] = (const float*)d_in[i];
    a.out = (float*)d_out; a.ws = (unsigned char*)d_ws;
#if MK_PER_PHASE
    { const int plist[] = {PHASE_LIST}; for (int p : plist) { a.ph_lo = p; a.ph_hi = p + 1; hipLaunchKernelGGL(fwd_mega, dim3(grid), dim3(512), LDS_BYTES, stream, a); } }
#else
    a.ph_lo = 0; a.ph_hi = NPHASE;
    void* args[] = {&a};
    hipError_t e = hipLaunchCooperativeKernel((const void*)fwd_mega, dim3(grid), dim3(512), args, LDS_BYTES, stream);
    if (e != hipSuccess) fprintf(stderr, "cooperative launch failed: %s (grid %d)\n", hipGetErrorString(e), grid);
#endif
}
```

```cpp
#include <hip/hip_runtime.h>
#include <hip/hip_cooperative_groups.h>
#include <cstdio>
#include <cstdint>
namespace cg = cooperative_groups;
#ifndef REP_LIST
#define REP_LIST 1,1,1,1,1,1,1,1,1,1,1,1,1,1,1,1
#endif
#ifndef PHASE_LIST
#define PHASE_LIST 0,1,2,3,4,5,6,7,8,9,10,11,12
#endif
#ifndef MK_PER_PHASE
#define MK_PER_PHASE 0
#endif
namespace pg8 {
#define PG8_LAS __attribute__((address_space(3)))
typedef unsigned short bf16_t;
typedef short bf16x8 __attribute__((ext_vector_type(8)));
typedef float f32x4 __attribute__((ext_vector_type(4)));
typedef unsigned u32x4 __attribute__((ext_vector_type(4)));
constexpr int BM = 256, BK = 64, HALF = 128, HTB = HALF * BK * 2  , STAGE_BYTES = 8 * HTB, NXCD = 8, WGM = 8;

__host__ __device__ __forceinline__ int lds_byte(int r, int c) { const int st = (r >> 4) * 2 + (c >> 5), rr = r & 15, cc = c & 31, ob = rr * 64 + cc * 2; return st * 1024 + (ob ^ (((ob >> 9) & 1) << 5)); }
__host__ __device__ __forceinline__ void stage_rc(int b, int& R, int& C) { const int st = b / 1024, sb = b % 1024, swz = sb ^ (((sb >> 9) & 1) << 5); R = (st >> 1) * 16 + swz / 64; C = (st & 1) * 32 + (swz % 64) / 2; }
__host__ __device__ __forceinline__ int perm32(int rho) { const int n = rho >> 4, i = rho & 15; return 8 * (i >> 2) + 4 * n + (i & 3); }

struct Unit { int pm, pn; };
struct Gemm { const bf16_t* A; const bf16_t* Bt; int M, N, K; };

struct StaticOrder {
    int nM, nN, nwg, G, c;
    __host__ __device__ void init(int M, int N, int G_, int c_) { nM = M / BM; nN = N / BM; nwg = nM * nN; G = G_; c = c_; }
    __host__ __device__ bool next(int i, Unit& u) const {
        const long L = (long)i * G + c; if (L >= nwg) return false;
        int wgid = (int)L; { const int q = nwg / NXCD, r = nwg % NXCD, xcd = wgid % NXCD, off = wgid / NXCD; wgid = (xcd < r ? xcd * (q + 1) : r * (q + 1) + (xcd - r) * q) + off; }
        const int nig = WGM * nN, gid = wgid / nig, fm = gid * WGM, gsz = (nM - fm) < WGM ? (nM - fm) : WGM;
        u.pm = fm + ((wgid % nig) % gsz); u.pn = (wgid % nig) / gsz; return true;
    }
    __device__ __forceinline__ void a_ready(const Unit&) const {}
    __device__ __forceinline__ void done(const Unit&) const {}
};

__device__ __forceinline__ unsigned cvt_pk_bf16(float lo, float hi) { unsigned r; asm volatile("v_cvt_pk_bf16_f32 %0, %1, %2" : "=v"(r) : "v"(lo), "v"(hi)); return r; }
template <class Epi, class Sched, bool ALIGN_EPI = false, bool SP2 = false>
__device__ __forceinline__ void gemm_phase(PG8_LAS unsigned char* lds, const Gemm g, const Sched& S, const Epi& E) {
    const int tid = threadIdx.x, wid = __builtin_amdgcn_readfirstlane(tid >> 6), lane = tid & 63, wr = wid >> 2, wc = wid & 3, fr = lane & 15, fq = lane >> 4;
    const int K = g.K, nt = K / BK;
    unsigned voffA[2], voffB[2];
#pragma unroll
    for (int i = 0; i < 2; ++i) { int R, C; stage_rc(tid * 16 + i * 8192, R, C); const int Rb = Epi::PERM ? ((R & ~31) + perm32(R & 31)) : R;
        voffA[i] = (unsigned)(R * K + C) * 2u; voffB[i] = (unsigned)(Rb * K + C) * 2u; }
    const size_t kstep = (size_t)(BK * 2);
    const size_t hstep = (size_t)HALF * K * 2;
    const size_t tstep = 2 * hstep;
    const unsigned ldsw = (unsigned)wid * 1024u;
    const int aoff = lds_byte(wr * 64 + fr, fq * 8), boff = lds_byte(wc * 32 + fr, fq * 8);
#define PG8_SA(b, h) (((b) * 2 + (h)) * HTB)
#define PG8_SB(b, h) ((4 + (b) * 2 + (h)) * HTB)
#define PG8_STAGE(bufoff, gbase, voff) do { _Pragma("unroll") for (int _i = 0; _i < 2; ++_i) \
        __builtin_amdgcn_global_load_lds((const unsigned*)((const char*)(gbase) + (voff)[_i]), (PG8_LAS unsigned*)(lds + (bufoff) + ldsw + _i * 8192), 16, 0, 0); } while (0)
#define PG8_LDA(dst, b, h) do { _Pragma("unroll") for (int m = 0; m < 4; ++m) _Pragma("unroll") for (int k = 0; k < 2; ++k) dst[m][k] = *(const PG8_LAS bf16x8*)(lds + PG8_SA(b, h) + aoff + m * 2048 + k * 1024); } while (0)
#define PG8_LDB(dst, b, h) do { _Pragma("unroll") for (int n = 0; n < 2; ++n) _Pragma("unroll") for (int k = 0; k < 2; ++k) dst[n][k] = *(const PG8_LAS bf16x8*)(lds + PG8_SB(b, h) + boff + n * 2048 + k * 1024); } while (0)
#define PG8_MMA(ai, bj, At, Bt) do { __builtin_amdgcn_s_setprio(1); _Pragma("unroll") for (int m = 0; m < 4; ++m) _Pragma("unroll") for (int n = 0; n < 2; ++n) _Pragma("unroll") for (int k = 0; k < 2; ++k) \
        acc[ai][bj][m][n] = __builtin_amdgcn_mfma_f32_16x16x32_bf16(Bt[n][k], At[m][k], acc[ai][bj][m][n], 0, 0, 0); __builtin_amdgcn_s_setprio(0); } while (0)
#define PG8_WAIT_V(n) asm volatile("s_waitcnt vmcnt(" #n ")" ::: "memory")
#define PG8_WAIT_L(n) asm volatile("s_waitcnt lgkmcnt(" #n ")" ::: "memory")
#define PG8_BAR __builtin_amdgcn_s_barrier()
#define PG8_SCHED __builtin_amdgcn_sched_barrier(0)
    Unit cur, nxt; int ui = 0;
    if (!S.next(0, cur)) return;
    f32x4 acc[2][2][4][2];
#pragma unroll
    for (int a = 0; a < 2; ++a)
#pragma unroll
        for (int b = 0; b < 2; ++b)
#pragma unroll
            for (int m = 0; m < 4; ++m)
#pragma unroll
                for (int n = 0; n < 2; ++n) acc[a][b][m][n] = (f32x4){0.f, 0.f, 0.f, 0.f};
    bf16x8 At[4][2], B0[2][2], B1[2][2];
    const char* cA = (const char*)g.A + (size_t)cur.pm * tstep; const char* cB = (const char*)g.Bt + (size_t)cur.pn * tstep;
    S.a_ready(cur);
    if constexpr (SP2) {
        PG8_STAGE(PG8_SB(0, 0), cB, voffB); PG8_STAGE(PG8_SB(0, 1), cB + hstep, voffB); PG8_STAGE(PG8_SA(0, 0), cA, voffA); PG8_STAGE(PG8_SA(0, 1), cA + hstep, voffA);
        if (wr == 1) PG8_BAR;
        PG8_WAIT_V(2); PG8_BAR;
        PG8_STAGE(PG8_SB(1, 0), cB + kstep, voffB); PG8_STAGE(PG8_SA(1, 0), cA + kstep, voffA); PG8_STAGE(PG8_SB(1, 1), cB + hstep + kstep, voffB);
        PG8_WAIT_V(6); PG8_BAR;
    } else {
        PG8_STAGE(PG8_SB(0, 0), cB, voffB); PG8_STAGE(PG8_SA(0, 0), cA, voffA); PG8_STAGE(PG8_SB(0, 1), cB + hstep, voffB); PG8_STAGE(PG8_SA(0, 1), cA + hstep, voffA);
        if (wr == 1) PG8_BAR;
        PG8_WAIT_V(4); PG8_BAR;
        PG8_STAGE(PG8_SB(1, 0), cB + kstep, voffB); PG8_STAGE(PG8_SA(1, 0), cA + kstep, voffA); PG8_STAGE(PG8_SB(1, 1), cB + hstep + kstep, voffB);
        PG8_WAIT_V(6); PG8_BAR;
    }
    for (;;) {
        const bool has_next = S.next(ui + 1, nxt);
        const char* nA = has_next ? (const char*)g.A + (size_t)nxt.pm * tstep : cA; const char* nB = has_next ? (const char*)g.Bt + (size_t)nxt.pn * tstep : cB;
        for (int t = 0; t < nt; t += 2) {
            const bool last = (t == nt - 2);
            const char* a1 = cA + (size_t)(t + 1) * kstep;
            const char* a2 = last ? nA : cA + (size_t)(t + 2) * kstep; const char* b2 = last ? nB : cB + (size_t)(t + 2) * kstep;
            const char* a3 = a2 + kstep; const char* b3 = b2 + kstep;
            if (last && has_next) S.a_ready(nxt);
            if constexpr (SP2) {
            PG8_LDB(B0, 0, 0); PG8_LDB(B1, 0, 1); PG8_SCHED; PG8_LDA(At, 0, 0); PG8_STAGE(PG8_SA(1, 1), a1 + hstep, voffA);
            PG8_WAIT_V(8); PG8_WAIT_L(0); PG8_BAR; PG8_MMA(0, 0, At, B0); PG8_MMA(0, 1, At, B1); PG8_BAR; PG8_SCHED;
            PG8_LDA(At, 0, 1); PG8_STAGE(PG8_SB(0, 0), b2, voffB); PG8_STAGE(PG8_SB(0, 1), b2 + hstep, voffB); PG8_STAGE(PG8_SA(0, 0), a2, voffA);
            PG8_WAIT_V(8); PG8_WAIT_L(0); PG8_BAR; PG8_MMA(1, 0, At, B0); PG8_MMA(1, 1, At, B1); PG8_BAR; PG8_SCHED;
            PG8_LDB(B0, 1, 0); PG8_LDB(B1, 1, 1); PG8_SCHED; PG8_LDA(At, 1, 0); PG8_STAGE(PG8_SA(0, 1), a2 + hstep, voffA);
            PG8_WAIT_V(8); PG8_WAIT_L(0); PG8_BAR; PG8_MMA(0, 0, At, B0); PG8_MMA(0, 1, At, B1); PG8_BAR; PG8_SCHED;
            PG8_LDA(At, 1, 1); PG8_STAGE(PG8_SB(1, 0), b3, voffB); PG8_STAGE(PG8_SB(1, 1), b3 + hstep, voffB); PG8_STAGE(PG8_SA(1, 0), a3, voffA);
            PG8_WAIT_V(8); PG8_WAIT_L(0); PG8_BAR; PG8_MMA(1, 0, At, B0); PG8_MMA(1, 1, At, B1); PG8_BAR; PG8_SCHED;
            } else {
            PG8_LDB(B0, 0, 0); PG8_SCHED; PG8_LDA(At, 0, 0); PG8_STAGE(PG8_SA(1, 1), a1 + hstep, voffA);
            PG8_WAIT_L(8); PG8_BAR; PG8_WAIT_L(0); PG8_MMA(0, 0, At, B0); PG8_BAR; PG8_SCHED;
            PG8_LDB(B1, 0, 1); PG8_STAGE(PG8_SB(0, 0), b2, voffB);
            PG8_BAR; PG8_WAIT_L(0); PG8_MMA(0, 1, At, B1); PG8_BAR;
            PG8_LDA(At, 0, 1); PG8_STAGE(PG8_SA(0, 0), a2, voffA);
            PG8_BAR; PG8_WAIT_L(0); PG8_MMA(1, 0, At, B0); PG8_BAR; PG8_SCHED;
            PG8_STAGE(PG8_SB(0, 1), b2 + hstep, voffB);
            PG8_WAIT_V(6); PG8_BAR; PG8_MMA(1, 1, At, B1); PG8_BAR;
            PG8_LDB(B0, 1, 0); PG8_SCHED; PG8_LDA(At, 1, 0); PG8_STAGE(PG8_SA(0, 1), a2 + hstep, voffA);
            PG8_WAIT_L(8); PG8_BAR; PG8_WAIT_L(0); PG8_MMA(0, 0, At, B0); PG8_BAR; PG8_SCHED;
            PG8_LDB(B1, 1, 1); PG8_STAGE(PG8_SB(1, 0), b3, voffB);
            PG8_BAR; PG8_WAIT_L(0); PG8_MMA(0, 1, At, B1); PG8_BAR;
            PG8_LDA(At, 1, 1); PG8_STAGE(PG8_SA(1, 0), a3, voffA);
            PG8_BAR; PG8_WAIT_L(0); PG8_MMA(1, 0, At, B0); PG8_BAR; PG8_SCHED;
            PG8_STAGE(PG8_SB(1, 1), b3 + hstep, voffB);
            PG8_WAIT_V(6); PG8_BAR; PG8_MMA(1, 1, At, B1); PG8_BAR;
            }
        }
        if constexpr (ALIGN_EPI) { if (wr == 0) PG8_BAR; }
        if constexpr (!Epi::AFTER_DRAIN) { E(acc, cur, wr, wc, fr, fq); S.done(cur); }
        if (!has_next) break;
#pragma unroll
        for (int a = 0; a < 2; ++a)
#pragma unroll
            for (int b = 0; b < 2; ++b)
#pragma unroll
                for (int m = 0; m < 4; ++m)
#pragma unroll
                    for (int n = 0; n < 2; ++n) acc[a][b][m][n] = (f32x4){0.f, 0.f, 0.f, 0.f};
        cur = nxt; cA = nA; cB = nB; ++ui;
        if constexpr (ALIGN_EPI) { if (wr == 1) PG8_BAR; }
    }
    PG8_WAIT_V(0);
    if constexpr (!ALIGN_EPI) { if (wr == 0) PG8_BAR; }
    PG8_BAR;
    if constexpr (Epi::AFTER_DRAIN) { E.fused(acc, cur, wr, wc, fr, fq, lds, wid, lane); S.done(cur); }
#undef PG8_SA
#undef PG8_SB
#undef PG8_STAGE
#undef PG8_LDA
#undef PG8_LDB
#undef PG8_MMA
#undef PG8_WAIT_V
#undef PG8_WAIT_L
#undef PG8_BAR
#undef PG8_SCHED
}
}

#define LAS __attribute__((address_space(3)))
typedef unsigned short bf16;
typedef pg8::bf16x8 bf16x8;
typedef pg8::f32x4 f32x4;
typedef pg8::u32x4 u32x4;
typedef unsigned u32x2 __attribute__((ext_vector_type(2)));

constexpr int D = 1024, TSEQ = 2048, MPROMPT = 16384, NSAMP = 128, MTOK = MPROMPT + NSAMP, MP = 16640;
constexpr int NZ = 8192, ZB = 0, ZC = 1024, ZX = 2048, ZQ = 3072, ZK = 3584, ZV = 4096, ZG = 5120, ZGA = 6144, ZGB = 7168;
constexpr int FF = 2816, PLE = 256, NWIN = 8208, GKCOL = 6144;
constexpr float EPS = 1e-6f;
constexpr size_t MiB = 1u << 20;
constexpr size_t WS_WIN = 0, WS_WA = 16 * MiB, WS_WB = 18 * MiB, WS_WO = 20 * MiB, WS_WPG = 22 * MiB, WS_WPP = 24 * MiB, WS_WGU = 25 * MiB, WS_WD = 36 * MiB;
constexpr size_t WS_GKLR = 42 * MiB, WS_PART = 44 * MiB, WS_DBUF = 46 * MiB, WS_SC = 47 * MiB, WS_KHT = 55 * MiB, WS_PB = 71 * MiB;
constexpr size_t WS_X1 = 80 * MiB, WS_X2 = 113 * MiB, WS_X3 = 146 * MiB, WS_X4 = 179 * MiB, WS_Z = 212 * MiB, WS_HID = WS_Z, WS_H = WS_Z + 96 * MiB, WS_H2 = WS_Z + 164 * MiB, WS_QT = 472 * MiB, WS_END = 488 * MiB;
constexpr size_t OUT_Y = 0, OUT_CONVP = (size_t)MTOK * D, OUT_GLAP = OUT_CONVP + 8 * 2 * 1024, OUT_CONVS = OUT_GLAP + (size_t)8 * 4 * 128 * 256, OUT_GLAS = OUT_CONVS + (size_t)128 * 2 * 1024;
constexpr int LDS_BYTES = 131072 + 256, LDS_BARST = 131072;
constexpr size_t WS_CTL = 45 * MiB + 256 * 1024, CTL_BYTES = 16384;

struct Args { const float* in[24]; float* out; unsigned char* ws; int ph_lo, ph_hi; };
constexpr int REP[16] = {REP_LIST};

struct Ctx {
    const float *xp, *xs, *st_conv, *st_gla, *pp, *ps, *w_pre, *w_in, *w_conv, *w_a, *w_gk, *b_gk, *w_gn, *w_b, *w_o, *w_post, *w_fpre, *w_fg, *w_fu, *w_fd, *w_fpost, *w_pp, *w_pg, *w_ppost;
    float* out;
    bf16 *WIN, *WA, *WB, *WO, *WPG, *WPP, *WGU, *WD, *PB, *X1, *X2, *X3, *X4, *Z, *HID, *KHT, *SC;
    float *GKLR, *PART, *DBUF; bf16 *QT, *WGK, *HB;
};

__device__ __forceinline__ float wave_sum(float v) {
#pragma unroll
    for (int o = 1; o < 64; o <<= 1) v += __shfl_xor(v, o);
    return v;
}
typedef float f32x2_t __attribute__((ext_vector_type(2))); typedef __bf16 bf16x2_t __attribute__((ext_vector_type(2)));
__device__ __forceinline__ unsigned pk2(float lo, float hi) { f32x2_t v = {lo, hi}; bf16x2_t b = __builtin_convertvector(v, bf16x2_t); return __builtin_bit_cast(unsigned, b); }
__device__ __forceinline__ float bf_lo(unsigned w) { return __uint_as_float(w << 16); }
__device__ __forceinline__ float bf_hi(unsigned w) { return __uint_as_float(w & 0xffff0000u); }
__device__ __forceinline__ float bf2f(bf16 b) { return __uint_as_float(((unsigned)b) << 16); }
__device__ __forceinline__ bf16 f2bf(float f) { return (bf16)(pk2(f, 0.f) & 0xffffu); }
__device__ __forceinline__ float sigm(float x) { return __builtin_amdgcn_rcpf(1.0f + __expf(-x)); }
__device__ __forceinline__ float siluf(float x) { return x * sigm(x); }
__device__ __forceinline__ float logsig(float g) { return fminf(g, 0.f) - __logf(1.0f + __expf(-fabsf(g))); }
__device__ __forceinline__ void unpack8(const u32x4 w, float (&v)[8]) {
    v[0] = bf_lo(w.x); v[1] = bf_hi(w.x); v[2] = bf_lo(w.y); v[3] = bf_hi(w.y); v[4] = bf_lo(w.z); v[5] = bf_hi(w.z); v[6] = bf_lo(w.w); v[7] = bf_hi(w.w);
}
__device__ __forceinline__ u32x4 pack8(const float (&v)[8]) { u32x4 w; w.x = pk2(v[0], v[1]); w.y = pk2(v[2], v[3]); w.z = pk2(v[4], v[5]); w.w = pk2(v[6], v[7]); return w; }

struct EpiStore {
    static constexpr bool PERM = true, AFTER_DRAIN = false;
    bf16* O; int ldc;
    __device__ __forceinline__ void operator()(const f32x4 (&acc)[2][2][4][2], const pg8::Unit& u, int wr, int wc, int fr, int fq) const {
        const int row0 = u.pm * 256 + wr * 64 + fr, col0 = u.pn * 256 + wc * 32 + 8 * fq;
#pragma unroll
        for (int ai = 0; ai < 2; ++ai)
#pragma unroll
            for (int m = 0; m < 4; ++m) { bf16* rowp = O + (size_t)(row0 + ai * 128 + m * 16) * ldc + col0;
#pragma unroll
                for (int bj = 0; bj < 2; ++bj) { const f32x4 v0 = acc[ai][bj][m][0], v1 = acc[ai][bj][m][1];
                    u32x4 w; w.x = pk2(v0[0], v0[1]); w.y = pk2(v0[2], v0[3]); w.z = pk2(v1[0], v1[1]); w.w = pk2(v1[2], v1[3]);
                    *(u32x4*)(rowp + bj * 128) = w; } }
    }
};
template <bool HAS_ADD> struct EpiGate {
    static constexpr bool PERM = true, AFTER_DRAIN = false;
    const bf16* zg; const bf16* add; bf16* O;
    __device__ __forceinline__ void operator()(const f32x4 (&acc)[2][2][4][2], const pg8::Unit& u, int wr, int wc, int fr, int fq) const {
        const int row0 = u.pm * 256 + wr * 64 + fr, col0 = u.pn * 256 + wc * 32 + 8 * fq;
#pragma unroll
        for (int ai = 0; ai < 2; ++ai)
#pragma unroll
            for (int m = 0; m < 4; ++m) { const size_t row = (size_t)(row0 + ai * 128 + m * 16);
#pragma unroll
                for (int bj = 0; bj < 2; ++bj) { const int col = col0 + bj * 128;
                    float g[8]; unpack8(__builtin_nontemporal_load((const u32x4*)(zg + row * NZ + col)), g);
                    const f32x4 v0 = acc[ai][bj][m][0], v1 = acc[ai][bj][m][1];
                    float o[8] = {v0[0], v0[1], v0[2], v0[3], v1[0], v1[1], v1[2], v1[3]};
#pragma unroll
                    for (int e = 0; e < 8; ++e) o[e] *= sigm(g[e]);
                    if (HAS_ADD) { float ad[8]; unpack8(__builtin_nontemporal_load((const u32x4*)(add + row * D + col)), ad);
#pragma unroll
                        for (int e = 0; e < 8; ++e) o[e] += ad[e]; }
                    *(u32x4*)(O + row * D + col) = pack8(o); } }
    }
};
template <bool MULSIG> struct EpiSq {
    static constexpr bool PERM = true, AFTER_DRAIN = false;
    bf16* O; const bf16* mul; float* part;
    __device__ __forceinline__ void operator()(const f32x4 (&acc)[2][2][4][2], const pg8::Unit& u, int wr, int wc, int fr, int fq) const {
        const int row0 = u.pm * 256 + wr * 64 + fr, col0 = u.pn * 256 + wc * 32 + 8 * fq;
#pragma unroll
        for (int ai = 0; ai < 2; ++ai)
#pragma unroll
            for (int m = 0; m < 4; ++m) { const size_t row = (size_t)(row0 + ai * 128 + m * 16); float s = 0.f;
#pragma unroll
                for (int bj = 0; bj < 2; ++bj) { const int col = col0 + bj * 128;
                    const f32x4 v0 = acc[ai][bj][m][0], v1 = acc[ai][bj][m][1];
                    float o[8] = {v0[0], v0[1], v0[2], v0[3], v1[0], v1[1], v1[2], v1[3]};
                    if (MULSIG) { float p[8]; unpack8(__builtin_nontemporal_load((const u32x4*)(mul + row * D + col)), p);
#pragma unroll
                        for (int e = 0; e < 8; ++e) o[e] = p[e] * sigm(o[e]); }
#pragma unroll
                    for (int e = 0; e < 8; ++e) s += o[e] * o[e];
                    *(u32x4*)(O + row * D + col) = pack8(o); }
                s += __shfl_xor(s, 16); s += __shfl_xor(s, 32);
                if (fq == 0) part[(size_t)(u.pn * 4 + wc) * MP + row] = s; }
    }
};
struct EpiSwiGLU {
    static constexpr bool PERM = true, AFTER_DRAIN = false;
    bf16* Hd;
    __device__ __forceinline__ void operator()(const f32x4 (&acc)[2][2][4][2], const pg8::Unit& u, int wr, int wc, int fr, int fq) const {
        const int row0 = u.pm * 256 + wr * 64 + fr, col0 = u.pn * 128 + wc * 32 + 8 * fq;
#pragma unroll
        for (int ai = 0; ai < 2; ++ai)
#pragma unroll
            for (int m = 0; m < 4; ++m) { const size_t row = (size_t)(row0 + ai * 128 + m * 16);
                const f32x4 g0 = acc[ai][0][m][0], g1 = acc[ai][0][m][1], u0 = acc[ai][1][m][0], u1 = acc[ai][1][m][1];
                float o[8];
#pragma unroll
                for (int e = 0; e < 4; ++e) { o[e] = siluf(g0[e]) * u0[e]; o[4 + e] = siluf(g1[e]) * u1[e]; }
                *(u32x4*)(Hd + row * FF + col0) = pack8(o); }
    }
};


constexpr size_t WS_WGK = 45 * MiB + 768 * 1024;
constexpr size_t WS_PARTS = 45 * MiB + 512 * 1024;
template <bool TWO, int NRB = 8, class F>
__device__ __forceinline__ void mini_gemm(const bf16* A, int row0, int n_rb, const bf16* Bt, int K, int ncu, int rot, const F& epi, LAS unsigned char* lds, int tid) {
    const int wave = tid >> 6, lane = tid & 63, l15 = lane & 15, quad = lane >> 4, G = gridDim.x;
    const int nsw = K >> 8;
    constexpr int NSUB = 8 / NRB;
    LAS f32x4* red = (LAS f32x4*)lds;
    for (int u = (int)((blockIdx.x + rot) % G); u < n_rb * NSUB * ncu; u += G) {
        const int cu = u % ncu, t_ = u / ncu, rowb = row0 + (t_ / NSUB) * 128 + (t_ % NSUB) * (16 * NRB);
        const bf16* ap = A + (size_t)(rowb + l15) * K + wave * (K >> 3) + quad * 8;
        const int brow = TWO ? ((16 * cu) >> 7) * 256 + ((16 * cu) & 127) : 16 * cu;
        const bf16* bp = Bt + (size_t)(brow + l15) * K + wave * (K >> 3) + quad * 8;
        f32x4 acc0[NRB], acc1[NRB];
#pragma unroll
        for (int r = 0; r < NRB; ++r) { acc0[r] = (f32x4){0.f, 0.f, 0.f, 0.f}; acc1[r] = (f32x4){0.f, 0.f, 0.f, 0.f}; }
        constexpr int KS = TWO ? 2 : (NRB == 8 ? 4 : 12);
        for (int s0 = 0; s0 < nsw; s0 += KS) {
            bf16x8 a[KS][NRB], b[KS], c[KS];
#pragma unroll
            for (int s = 0; s < KS; ++s) { const bool on = s0 + s < nsw; const int ko = (s0 + s) * 32;
                b[s] = on ? *(const bf16x8*)(bp + ko) : (bf16x8){0, 0, 0, 0, 0, 0, 0, 0}; if (TWO) c[s] = on ? *(const bf16x8*)(bp + (size_t)128 * K + ko) : (bf16x8){0, 0, 0, 0, 0, 0, 0, 0};
#pragma unroll
                for (int r = 0; r < NRB; ++r) a[s][r] = on ? *(const bf16x8*)(ap + (size_t)(16 * r) * K + ko) : (bf16x8){0, 0, 0, 0, 0, 0, 0, 0}; }
#pragma unroll
            for (int s = 0; s < KS; ++s)
#pragma unroll
                for (int r = 0; r < NRB; ++r) { acc0[r] = __builtin_amdgcn_mfma_f32_16x16x32_bf16(b[s], a[s][r], acc0[r], 0, 0, 0); if (TWO) acc1[r] = __builtin_amdgcn_mfma_f32_16x16x32_bf16(c[s], a[s][r], acc1[r], 0, 0, 0); }
        }
        f32x4 t0 = (f32x4){0.f, 0.f, 0.f, 0.f}, t1 = (f32x4){0.f, 0.f, 0.f, 0.f};
#pragma unroll
        for (int r = 0; r < NRB; ++r) red[(wave * NRB + r) * 64 + lane] = acc0[r];
        __syncthreads();
        if (wave < NRB) {
#pragma unroll
            for (int s = 0; s < 8; ++s) t0 += red[(s * NRB + wave) * 64 + lane]; }
        __syncthreads();
        if (TWO) {
#pragma unroll
            for (int r = 0; r < NRB; ++r) red[(wave * NRB + r) * 64 + lane] = acc1[r];
            __syncthreads();
            if (wave < NRB) {
#pragma unroll
                for (int s = 0; s < 8; ++s) t1 += red[(s * NRB + wave) * 64 + lane]; }
            __syncthreads();
        }
        if (wave < NRB) epi(cu, rowb + 16 * wave + l15, 16 * cu + 4 * quad, t0, t1);
    }
}
struct MiniF32 { float* O; int ldc; __device__ __forceinline__ void operator()(int, int row, int col, const f32x4 v, const f32x4) const { *(f32x4*)(O + (size_t)row * ldc + col) = v; } };
__device__ __forceinline__ void st4(bf16* p, const f32x4 v) { *(u32x2*)p = (u32x2){pk2(v[0], v[1]), pk2(v[2], v[3])}; }
__device__ __forceinline__ f32x4 ld4(const bf16* p) { const u32x2 w = *(const u32x2*)p; return (f32x4){bf_lo(w.x), bf_hi(w.x), bf_lo(w.y), bf_hi(w.y)}; }
__device__ __forceinline__ f32x4 sig4(const f32x4 g) { return (f32x4){sigm(g[0]), sigm(g[1]), sigm(g[2]), sigm(g[3])}; }
struct MiniStore { bf16* O; int ldc; __device__ __forceinline__ void operator()(int, int row, int col, const f32x4 v, const f32x4) const { st4(O + (size_t)row * ldc + col, v); } };
template <bool HAS_ADD> struct MiniGate { const bf16* zg; const bf16* add; bf16* O;
    __device__ __forceinline__ void operator()(int, int row, int col, const f32x4 v, const f32x4) const { f32x4 o = sig4(ld4(zg + (size_t)row * NZ + col)) * v; if (HAS_ADD) o += ld4(add + (size_t)row * D + col); st4(O + (size_t)row * D + col, o); } };
template <bool MULSIG> struct MiniSq { bf16* O; const bf16* mul; float* parts;
    __device__ __forceinline__ void operator()(int u, int row, int col, const f32x4 v, const f32x4) const { f32x4 o = v; if (MULSIG) o = ld4(mul + (size_t)row * D + col) * sig4(v);
        st4(O + (size_t)row * D + col, o); float s = (o[0] * o[0] + o[1] * o[1]) + (o[2] * o[2] + o[3] * o[3]); s += __shfl_xor(s, 16); s += __shfl_xor(s, 32);
        if ((threadIdx.x & 63) < 16) parts[(size_t)u * NSAMP + (row - MPROMPT)] = s; } };
struct MiniSwiGLU { bf16* Hd; __device__ __forceinline__ void operator()(int, int row, int col, const f32x4 g, const f32x4 up) const { st4(Hd + (size_t)row * FF + col, (f32x4){siluf(g[0]) * up[0], siluf(g[1]) * up[1], siluf(g[2]) * up[2], siluf(g[3]) * up[3]}); } };

template <bool WT_NT = true>
__device__ __forceinline__ void p0_transpose_item(const float* W, int ldn, int k0, int nsrc0, bf16* WT, int K, int drow0, LAS float* scr, int lane) {
    float tv[32];
#pragma unroll
    for (int i = 0; i < 32; ++i) tv[i] = __builtin_nontemporal_load(W + (size_t)(k0 + 2 * i + (lane >> 5)) * ldn + nsrc0 + (lane & 31));
#pragma unroll
    for (int i = 0; i < 32; ++i) scr[(2 * i + (lane >> 5)) * 33 + (lane & 31)] = tv[i];
    asm volatile("s_waitcnt lgkmcnt(0)" ::: "memory");
    const int c = lane & 7;
#pragma unroll
    for (int j = 0; j < 4; ++j) { const int n = (lane >> 3) + 8 * j; const LAS float* s = scr + (8 * c) * 33 + n;
        u32x4 o; o.x = pk2(s[0 * 33], s[1 * 33]); o.y = pk2(s[2 * 33], s[3 * 33]); o.z = pk2(s[4 * 33], s[5 * 33]); o.w = pk2(s[6 * 33], s[7 * 33]);
        if (WT_NT) __builtin_nontemporal_store(o, (u32x4*)(WT + (size_t)(drow0 + n) * K + k0 + 8 * c)); else *(u32x4*)(WT + (size_t)(drow0 + n) * K + k0 + 8 * c) = o; }
    asm volatile("s_waitcnt lgkmcnt(0)" ::: "memory");
}
__device__ __forceinline__ void p0_items(const Ctx& C, LAS unsigned char* lds, int tid, bool late) {
    const int wave = tid >> 6, lane = tid & 63, gw = blockIdx.x * 8 + wave, NGW = gridDim.x * 8;
    LAS float* scr = (LAS float*)(lds + wave * 8704);
    constexpr int I_IN = 16 * 256, I_SQ = 16 * 32, I_PP = 4 * 32, I_GU = 16 * 176, I_FD = 44 * 32;
    constexpr int NITEMS = I_IN + 4 * I_SQ + I_PP + I_GU + I_FD;
    const int lo = late ? I_IN : 0, hi = late ? NITEMS : I_IN;
    for (int it = lo + gw; it < hi; it += NGW) {
        int r = it;
        if (r < I_IN) { const int kb = r >> 8, nb = r & 255; p0_transpose_item<false>(C.w_in, NWIN, 64 * kb, 32 * nb + (32 * nb >= GKCOL ? 16 : 0), C.WIN, D, 32 * nb, scr, lane); continue; } r -= I_IN;
        if (r < 4 * I_SQ) { const int w = r / I_SQ, q = r % I_SQ, kb = q >> 5, nb = q & 31; const float* src = w == 0 ? C.w_a : w == 1 ? C.w_b : w == 2 ? C.w_o : C.w_pg; bf16* dst = w == 0 ? C.WA : w == 1 ? C.WB : w == 2 ? C.WO : C.WPG;
            p0_transpose_item(src, D, 64 * kb, 32 * nb, dst, D, 32 * nb, scr, lane); continue; } r -= 4 * I_SQ;
        if (r < I_PP) { const int kb = r >> 5, nb = r & 31; p0_transpose_item(C.w_pp, D, 64 * kb, 32 * nb, C.WPP, PLE, 32 * nb, scr, lane); continue; } r -= I_PP;
        if (r < I_GU) { const int kb = r / 176, nb = r % 176, tile = nb >> 3, w = nb & 7; p0_transpose_item(w < 4 ? C.w_fg : C.w_fu, FF, 64 * kb, 128 * tile + 32 * (w & 3), C.WGU, D, 32 * nb, scr, lane); continue; } r -= I_GU;
        { const int kb = r >> 5, nb = r & 31; p0_transpose_item(C.w_fd, D, 64 * kb, 32 * nb, C.WD, FF, 32 * nb, scr, lane); }
    }
}
__device__ __forceinline__ void p0_late(const Ctx& C, LAS unsigned char* lds, int tid) {
    p0_items(C, lds, tid, true);
    for (int idx = blockIdx.x * 512 + tid; idx < MP * 32; idx += gridDim.x * 512) {
        const int row = idx >> 5, c8 = (idx & 31) * 8; u32x4 o = (u32x4){0u, 0u, 0u, 0u};
        if (row < MTOK) { const float* src = row < MPROMPT ? C.pp + (size_t)row * PLE + c8 : C.ps + (size_t)(row - MPROMPT) * PLE + c8;
            const f32x4 a = __builtin_nontemporal_load((const f32x4*)src), b = __builtin_nontemporal_load((const f32x4*)(src + 4)); o.x = pk2(a[0], a[1]); o.y = pk2(a[2], a[3]); o.z = pk2(b[0], b[1]); o.w = pk2(b[2], b[3]); }
        __builtin_nontemporal_store(o, (u32x4*)(C.PB + (size_t)row * PLE + c8));
    }
}
__device__ __forceinline__ void p0_prologue(const Ctx& C, LAS unsigned char* lds, int tid) {
    const int wave = tid >> 6, lane = tid & 63, gw = blockIdx.x * 8 + wave, NGW = gridDim.x * 8;
    p0_items(C, lds, tid, false);
    for (int idx = blockIdx.x * 512 + tid; idx < D * 16; idx += gridDim.x * 512) { const int c = idx >> 4, r = idx & 15; C.WGK[r * D + c] = f2bf(C.w_in[(size_t)c * NWIN + GKCOL + r]); }
    f32x4 wp[4];
#pragma unroll
    for (int j = 0; j < 4; ++j) wp[j] = *(const f32x4*)(C.w_pre + 4 * lane + 256 * j);
    for (int m0 = gw; m0 < MTOK; m0 += 4 * NGW) {
        f32x4 v[4][4];
#pragma unroll
        for (int r = 0; r < 4; ++r) { const int m = m0 + r * NGW;
#pragma unroll
            for (int j = 0; j < 4; ++j) { v[r][j] = (f32x4){0.f, 0.f, 0.f, 0.f};
                if (m < MTOK) v[r][j] = __builtin_nontemporal_load((const f32x4*)(m < MPROMPT ? C.xp + (size_t)m * D + 4 * lane + 256 * j : C.xs + (size_t)(m - MPROMPT) * D + 4 * lane + 256 * j)); } }
#pragma unroll
        for (int r = 0; r < 4; ++r) { const int m = m0 + r * NGW; if (m >= MTOK) continue;
            float s = 0.f;
#pragma unroll
            for (int j = 0; j < 4; ++j) s += (v[r][j][0] * v[r][j][0] + v[r][j][1] * v[r][j][1]) + (v[r][j][2] * v[r][j][2] + v[r][j][3] * v[r][j][3]);
            const float rstd = 1.0f / sqrtf(wave_sum(s) * (1.0f / D) + EPS);
#pragma unroll
            for (int j = 0; j < 4; ++j) { const f32x4 o = v[r][j] * rstd * wp[j]; *(u32x2*)(C.X1 + (size_t)m * D + 4 * lane + 256 * j) = (u32x2){pk2(o[0], o[1]), pk2(o[2], o[3])}; } }
    }
}

struct PrepRegs { float wg[16]; float bias; f32x4 gk; bf16 q[16], k[16]; };
__device__ __forceinline__ void prep_load(const Ctx& C, int item, int tid, PrepRegs& R) {
    const int b = item >> 7, h = (item >> 5) & 3, n = item & 31, row0 = b * TSEQ + n * 64, col = tid & 127, rg = tid >> 7;
    R.gk = ((const f32x4*)(C.GKLR + (size_t)row0 * 16))[tid & 255];
#pragma unroll
    for (int r = 0; r < 16; ++r) R.wg[r] = C.w_gk[r * 512 + h * 128 + col];
    R.bias = C.b_gk[h * 128 + col];
    const bf16* zq = C.Z + (size_t)(row0 + rg * 16) * NZ + ZQ + h * 128 + col;
    const bf16* zk = C.Z + (size_t)(row0 + rg * 16) * NZ + ZK + h * 128 + col;
#pragma unroll
    for (int ii = 0; ii < 16; ++ii) { R.q[ii] = __builtin_nontemporal_load(zq + (size_t)ii * NZ); R.k[ii] = __builtin_nontemporal_load(zk + (size_t)ii * NZ); }
}
__device__ __forceinline__ void gla_prep_item(const Ctx& C, int item, LAS unsigned char* lds, int tid, const PrepRegs& R) {
    const int b = item >> 7, h = (item >> 5) & 3, n = item & 31, row0 = b * TSEQ + n * 64;
    LAS float* gkl = (LAS float*)lds;
    LAS float* csum = (LAS float*)(lds + 4096);
    LAS bf16* Qs = (LAS bf16*)(lds + 8192);
    LAS bf16* Ks = (LAS bf16*)(lds + 8192 + 17408);
    const int col = tid & 127, rg = tid >> 7;
    if (tid < 256) ((LAS f32x4*)gkl)[tid] = R.gk;
    const float bias = R.bias;
    __syncthreads();
    float bl[16]; float c = 0.f;
#pragma unroll
    for (int i = 0; i < 16; ++i) { const int row = rg * 16 + i; float g = bias;
#pragma unroll
        for (int r = 0; r < 16; ++r) g += gkl[row * 16 + r] * R.wg[r];
        c += logsig(g) * (1.0f / 16.0f); bl[i] = c; }
    csum[rg * 128 + col] = c;
    __syncthreads();
    const float c0 = csum[col], c1 = csum[128 + col], c2 = csum[256 + col], c3 = csum[384 + col];
    const float off = rg == 0 ? 0.f : rg == 1 ? c0 : rg == 2 ? c0 + c1 : c0 + c1 + c2;
    const float bm = c0 + c1, blast = bm + c2 + c3;
    bf16* qt = C.QT + (size_t)(row0 + rg * 16) * 512 + h * 128 + col;
    const float scale = 0.08838834764831845f;
    unsigned khp[8];
#pragma unroll
    for (int i = 0; i < 16; i += 2) {
        float kh2[2];
#pragma unroll
        for (int e = 0; e < 2; ++e) { const int ii = i + e; const float bb = bl[ii] + off; const float q = bf2f(R.q[ii]) * scale, k = bf2f(R.k[ii]);
            qt[(size_t)ii * 512] = f2bf(q * __expf(bb));
            Qs[(rg * 16 + ii) * 136 + col] = f2bf(q * __expf(bb - bm)); Ks[(rg * 16 + ii) * 136 + col] = f2bf(k * __expf(bm - bb));
            kh2[e] = k * __expf(blast - bb); }
        khp[i >> 1] = pk2(kh2[0], kh2[1]);
    }
    { bf16* dst = C.KHT + ((size_t)item * 128 + col) * 64 + rg * 16;
      *(u32x4*)dst = (u32x4){khp[0], khp[1], khp[2], khp[3]}; *(u32x4*)(dst + 8) = (u32x4){khp[4], khp[5], khp[6], khp[7]}; }
    if (rg == 0) C.DBUF[(size_t)item * 128 + col] = __expf(blast);
    __syncthreads();
    const int wave = tid >> 6, lane = tid & 63, l15 = lane & 15, quad = lane >> 4, tr = wave >> 1;
#pragma unroll
    for (int cc = 0; cc < 2; ++cc) { const int tc = (wave & 1) * 2 + cc; u32x2 ow = (u32x2){0u, 0u};
        const int t = tr * 16 + l15, s0 = tc * 16 + quad * 4;
        if (tc <= tr) { f32x4 acc = (f32x4){0.f, 0.f, 0.f, 0.f};
#pragma unroll
            for (int kk = 0; kk < 4; ++kk) { const bf16x8 a = *(const LAS bf16x8*)(Ks + (tc * 16 + l15) * 136 + kk * 32 + quad * 8), bq = *(const LAS bf16x8*)(Qs + (tr * 16 + l15) * 136 + kk * 32 + quad * 8);
                acc = __builtin_amdgcn_mfma_f32_16x16x32_bf16(a, bq, acc, 0, 0, 0); }
#pragma unroll
            for (int j = 0; j < 4; ++j) if (s0 + j > t) acc[j] = 0.f;
            ow.x = pk2(acc[0], acc[1]); ow.y = pk2(acc[2], acc[3]); }
        *(u32x2*)(C.SC + ((size_t)item * 64 + t) * 64 + s0) = ow; }
    __syncthreads();
}
__device__ __forceinline__ void gla_sample_item(const Ctx& C, int item, LAS unsigned char* lds, int tid) {
    const int s = item >> 2, h = item & 3, m = MPROMPT + s, wave = tid >> 6, lane = tid & 63;
    LAS float* av = (LAS float*)lds; LAS float* qs = av + 128; LAS float* kk = av + 256; LAS float* vv = av + 384; LAS float* part = (LAS float*)(lds + 4096);
    const bf16* zr = C.Z + (size_t)m * NZ;
    const f32x4* S0 = (const f32x4*)(C.st_gla + (size_t)item * 128 * 256); f32x4* So = (f32x4*)(C.out + OUT_GLAS + (size_t)item * 128 * 256);
    f32x4 s0v[16];
#pragma unroll
    for (int it = 0; it < 16; ++it) s0v[it] = __builtin_nontemporal_load(S0 + (it * 8 + wave) * 64 + lane);
    const f32x4 wn = *(const f32x4*)(C.w_gn + 4 * lane); const u32x2 gw = *(const u32x2*)(zr + ZG + h * 256 + 4 * lane);
    if (tid < 128) { float g = C.b_gk[h * 128 + tid];
#pragma unroll
        for (int r = 0; r < 16; ++r) g += C.GKLR[(size_t)m * 16 + r] * C.w_gk[r * 512 + h * 128 + tid];
        av[tid] = __expf(logsig(g) * (1.0f / 16.0f)); qs[tid] = bf2f(zr[ZQ + h * 128 + tid]) * 0.08838834764831845f; kk[tid] = bf2f(zr[ZK + h * 128 + tid]); }
    else if (tid < 384) vv[tid - 128] = bf2f(zr[ZV + h * 256 + tid - 128]);
    __syncthreads();
    const f32x4 v4 = ((const LAS f32x4*)vv)[lane]; f32x4 o = (f32x4){0.f, 0.f, 0.f, 0.f};
#pragma unroll
    for (int it = 0; it < 16; ++it) { const int k = it * 8 + wave; const f32x4 s0 = s0v[it]; const f32x4 sn = s0 * av[k] + v4 * kk[k]; __builtin_nontemporal_store(sn, So + k * 64 + lane); o += sn * qs[k]; }
    ((LAS f32x4*)(part + wave * 256))[lane] = o;
    __syncthreads();
    if (wave == 0) { f32x4 t = (f32x4){0.f, 0.f, 0.f, 0.f};
#pragma unroll
        for (int w = 0; w < 8; ++w) t += ((const LAS f32x4*)(part + w * 256))[lane];
        const float ss = wave_sum((t[0] * t[0] + t[1] * t[1]) + (t[2] * t[2] + t[3] * t[3]));
        const float rstd = 1.0f / sqrtf(ss * (1.0f / 256.0f) + EPS);
        const float g0 = bf_lo(gw.x), g1 = bf_hi(gw.x), g2 = bf_lo(gw.y), g3 = bf_hi(gw.y);
        *(u32x2*)(C.X3 + (size_t)m * D + h * 256 + 4 * lane) = (u32x2){pk2(t[0] * rstd * wn[0] * siluf(g0), t[1] * rstd * wn[1] * siluf(g1)), pk2(t[2] * rstd * wn[2] * siluf(g2), t[3] * rstd * wn[3] * siluf(g3))}; }
    __syncthreads();
}
__device__ __forceinline__ void conv_phase(const Ctx& C, int tid) {
    for (int idx = blockIdx.x * 512 + tid; idx < 1024 * 128; idx += gridDim.x * 512) {
        const int c8 = (idx & 127) * 8, seg = idx >> 7, m0 = seg * 16, tpos0 = m0 & (TSEQ - 1);
        float w0[8], w1[8], w2[8], u1[8], u2[8];
#pragma unroll
        for (int e = 0; e < 8; ++e) { w0[e] = C.w_conv[c8 + e]; w1[e] = C.w_conv[D + c8 + e]; w2[e] = C.w_conv[2 * D + c8 + e]; u1[e] = 0.f; u2[e] = 0.f; }
        u32x4 vbA[4], vcA[4], vxA[4], vbB[4], vcB[4], vxB[4];
#define CV_LOAD(X, rr) do { _Pragma("unroll") for (int i = 0; i < 4; ++i) { const bf16* zr = C.Z + (size_t)(m0 + (rr) + i) * NZ; \
            vb##X[i] = __builtin_nontemporal_load((const u32x4*)(zr + ZB + c8)); vc##X[i] = __builtin_nontemporal_load((const u32x4*)(zr + ZC + c8)); vx##X[i] = __builtin_nontemporal_load((const u32x4*)(zr + ZX + c8)); } } while (0)
#define CV_COMP(X, rr) do { _Pragma("unroll") for (int i = 0; i < 4; ++i) { const int m = m0 + (rr) + i, tpos = tpos0 + (rr) + i; float ba[8], ca[8], xa[8], o[8], u0[8]; \
            unpack8(vb##X[i], ba); unpack8(vc##X[i], ca); unpack8(vx##X[i], xa); \
            _Pragma("unroll") for (int e = 0; e < 8; ++e) { u0[e] = ca[e] * xa[e]; o[e] = ba[e] * (w0[e] * u2[e] + w1[e] * u1[e] + w2[e] * u0[e]); u2[e] = u1[e]; u1[e] = u0[e]; } \
            __builtin_nontemporal_store(pack8(o), (u32x4*)(C.X2 + (size_t)m * D + c8)); \
            if (tpos >= TSEQ - 2) { float* dst = C.out + OUT_CONVP + ((size_t)(m >> 11) * 2 + (tpos - (TSEQ - 2))) * D + c8; \
                *(f32x4*)dst = (f32x4){u0[0], u0[1], u0[2], u0[3]}; *(f32x4*)(dst + 4) = (f32x4){u0[4], u0[5], u0[6], u0[7]}; } } } while (0)
        CV_LOAD(A, 0); CV_LOAD(B, 4);
        if (tpos0 != 0) { float ca[8], xa[8]; const bf16* zr = C.Z + (size_t)(m0 - 1) * NZ;
            unpack8(*(const u32x4*)(zr + ZC + c8), ca); unpack8(*(const u32x4*)(zr + ZX + c8), xa);
#pragma unroll
            for (int e = 0; e < 8; ++e) u1[e] = ca[e] * xa[e];
            unpack8(*(const u32x4*)(zr - NZ + ZC + c8), ca); unpack8(*(const u32x4*)(zr - NZ + ZX + c8), xa);
#pragma unroll
            for (int e = 0; e < 8; ++e) u2[e] = ca[e] * xa[e]; }
        CV_COMP(A, 0); CV_LOAD(A, 8); CV_COMP(B, 4); CV_LOAD(B, 12); CV_COMP(A, 8); CV_COMP(B, 12);
#undef CV_LOAD
#undef CV_COMP
    }
    for (int idx = blockIdx.x * 512 + tid; idx < NSAMP * 128; idx += gridDim.x * 512) {
        const int s = idx >> 7, c8 = (idx & 127) * 8, m = MPROMPT + s;
        const bf16* zr = C.Z + (size_t)m * NZ;
        float ba[8], ca[8], xa[8], o[8];
        unpack8(*(const u32x4*)(zr + ZB + c8), ba); unpack8(*(const u32x4*)(zr + ZC + c8), ca); unpack8(*(const u32x4*)(zr + ZX + c8), xa);
        const float* b0 = C.st_conv + ((size_t)s * 2 + 0) * D + c8; const float* b1 = b0 + D;
        float* d0 = C.out + OUT_CONVS + ((size_t)s * 2 + 0) * D + c8; float* d1 = d0 + D;
#pragma unroll
        for (int e = 0; e < 8; ++e) { const float u0 = ca[e] * xa[e], p0 = b0[e], p1 = b1[e];
            o[e] = ba[e] * (C.w_conv[c8 + e] * p0 + C.w_conv[D + c8 + e] * p1 + C.w_conv[2 * D + c8 + e] * u0); d0[e] = p1; d1[e] = u0; }
        *(u32x4*)(C.X2 + (size_t)m * D + c8) = pack8(o);
    }
}

__device__ __forceinline__ void gla_scan_item(const Ctx& C, int item, LAS unsigned char* lds, int tid) {
    const int jx = item >> 3, bh = (item & 7) * 4 + (jx >> 3), sl = jx & 7, b = bh >> 2, h = bh & 3;
    LAS bf16* Aq = (LAS bf16*)lds;
    LAS bf16* Bc = (LAS bf16*)(lds + 25600);
    LAS bf16* Kt = (LAS bf16*)(lds + 38400);
    const int wave = tid >> 6, lane = tid & 63, l15 = lane & 15, quad = lane >> 4;
    f32x4 S[2] = {(f32x4){0.f, 0.f, 0.f, 0.f}, (f32x4){0.f, 0.f, 0.f, 0.f}};
    *(LAS u32x4*)(Bc + (tid >> 4) * 200 + (tid & 15) * 8) = (u32x4){0u, 0u, 0u, 0u};
    u32x4 rq0A, rq1A, rsA, rk0A, rk1A, rvA = (u32x4){0u, 0u, 0u, 0u}; f32x4 rdA;
    u32x4 rq0B, rq1B, rsB, rk0B, rk1B, rvB = (u32x4){0u, 0u, 0u, 0u}; f32x4 rdB;
#define SCAN_LOAD(X, n) do { const size_t itn = (size_t)bh * 32 + (n); const size_t r0 = (size_t)b * TSEQ + (size_t)(n) * 64; \
        rq0##X = *(const u32x4*)(C.QT + (r0 + (tid >> 4)) * 512 + h * 128 + (tid & 15) * 8); rq1##X = *(const u32x4*)(C.QT + (r0 + 32 + (tid >> 4)) * 512 + h * 128 + (tid & 15) * 8); \
        rs##X = *(const u32x4*)(C.SC + (itn * 64 + (tid >> 3)) * 64 + (tid & 7) * 8); \
        rk0##X = *(const u32x4*)(C.KHT + (itn * 128 + (tid >> 3)) * 64 + (tid & 7) * 8); rk1##X = *(const u32x4*)(C.KHT + (itn * 128 + 64 + (tid >> 3)) * 64 + (tid & 7) * 8); \
        rv##X = *(const u32x4*)(C.Z + (r0 + ((tid & 255) >> 2)) * NZ + ZV + h * 256 + sl * 32 + (tid & 3) * 8); \
        rd##X = *(const f32x4*)(C.DBUF + itn * 128 + wave * 16 + quad * 4); } while (0)
#define SCAN_STEP(X, n) do { \
        *(LAS u32x4*)(Aq + (tid >> 4) * 200 + (tid & 15) * 8) = rq0##X; *(LAS u32x4*)(Aq + (32 + (tid >> 4)) * 200 + (tid & 15) * 8) = rq1##X; \
        *(LAS u32x4*)(Aq + (tid >> 3) * 200 + 128 + (tid & 7) * 8) = rs##X; \
        *(LAS u32x4*)(Kt + (tid >> 3) * 72 + (tid & 7) * 8) = rk0##X; *(LAS u32x4*)(Kt + (64 + (tid >> 3)) * 72 + (tid & 7) * 8) = rk1##X; \
        if (tid < 256) { const int t = tid >> 2, c = (tid & 3) * 8; LAS bf16* d = Bc + c * 200 + 128 + t; \
            d[0] = (bf16)(rv##X.x & 0xffffu); d[200] = (bf16)(rv##X.x >> 16); d[400] = (bf16)(rv##X.y & 0xffffu); d[600] = (bf16)(rv##X.y >> 16); \
            d[800] = (bf16)(rv##X.z & 0xffffu); d[1000] = (bf16)(rv##X.z >> 16); d[1200] = (bf16)(rv##X.w & 0xffffu); d[1400] = (bf16)(rv##X.w >> 16); } \
        const f32x4 dcur = rd##X; \
        const size_t tok0 = (size_t)b * TSEQ + (size_t)(n) * 64; \
        if ((n) + 2 < 32) SCAN_LOAD(X, (n) + 2); \
        __syncthreads(); \
        { const int vt = wave & 1, tt = wave >> 1; f32x4 acc = (f32x4){0.f, 0.f, 0.f, 0.f}; \
          _Pragma("unroll") for (int kk = 0; kk < 6; ++kk) { const bf16x8 a = *(const LAS bf16x8*)(Bc + (vt * 16 + l15) * 200 + kk * 32 + quad * 8), bq = *(const LAS bf16x8*)(Aq + (tt * 16 + l15) * 200 + kk * 32 + quad * 8); \
              acc = __builtin_amdgcn_mfma_f32_16x16x32_bf16(a, bq, acc, 0, 0, 0); } \
          *(u32x2*)(C.X4 + (tok0 + tt * 16 + l15) * D + h * 256 + sl * 32 + vt * 16 + quad * 4) = (u32x2){pk2(acc[0], acc[1]), pk2(acc[2], acc[3])}; } \
        _Pragma("unroll") for (int v2 = 0; v2 < 2; ++v2) { S[v2] = S[v2] * dcur; \
            _Pragma("unroll") for (int kk = 0; kk < 2; ++kk) { const bf16x8 a = *(const LAS bf16x8*)(Kt + (wave * 16 + l15) * 72 + kk * 32 + quad * 8), bq = *(const LAS bf16x8*)(Bc + (v2 * 16 + l15) * 200 + 128 + kk * 32 + quad * 8); \
                S[v2] = __builtin_amdgcn_mfma_f32_16x16x32_bf16(a, bq, S[v2], 0, 0, 0); } } \
        __syncthreads(); \
        _Pragma("unroll") for (int v2 = 0; v2 < 2; ++v2) *(LAS u32x2*)(Bc + (v2 * 16 + l15) * 200 + wave * 16 + quad * 4) = (u32x2){pk2(S[v2][0], S[v2][1]), pk2(S[v2][2], S[v2][3])}; \
    } while (0)
    SCAN_LOAD(A, 0); SCAN_LOAD(B, 1);
#pragma unroll
    for (int n = 0; n < 32; n += 2) { SCAN_STEP(A, n); SCAN_STEP(B, n + 1); }
#undef SCAN_STEP
#undef SCAN_LOAD
    float* So = C.out + OUT_GLAP + ((size_t)bh * 128 + wave * 16 + quad * 4) * 256 + sl * 32 + l15;
#pragma unroll
    for (int v2 = 0; v2 < 2; ++v2)
#pragma unroll
        for (int j = 0; j < 4; ++j) So[(size_t)j * 256 + v2 * 16] = S[v2][j];
    __syncthreads();
}

__device__ __forceinline__ void p4_onorm(const Ctx& C, int tid) {
    const int wave = tid >> 6, lane = tid & 63, gw = blockIdx.x * 8 + wave, NGW = gridDim.x * 8;
    const f32x4 wn = *(const f32x4*)(C.w_gn + 4 * lane);
    for (int m0 = gw; m0 < MPROMPT; m0 += 4 * NGW) {
        u32x2 ov[4][4], gv[4][4];
#pragma unroll
        for (int r = 0; r < 4; ++r) { const int m = m0 + r * NGW;
#pragma unroll
            for (int j = 0; j < 4; ++j) { ov[r][j] = (u32x2){0u, 0u}; gv[r][j] = (u32x2){0u, 0u};
                if (m < MPROMPT) { ov[r][j] = __builtin_nontemporal_load((const u32x2*)(C.X4 + (size_t)m * D + 4 * lane + 256 * j)); gv[r][j] = __builtin_nontemporal_load((const u32x2*)(C.Z + (size_t)m * NZ + ZG + 4 * lane + 256 * j)); } } }
#pragma unroll
        for (int r = 0; r < 4; ++r) { const int m = m0 + r * NGW; if (m >= MPROMPT) continue;
#pragma unroll
            for (int j = 0; j < 4; ++j) { const u32x2 ow = ov[r][j], gw2 = gv[r][j];
                const float o0 = bf_lo(ow.x), o1 = bf_hi(ow.x), o2 = bf_lo(ow.y), o3 = bf_hi(ow.y);
                const float rstd = 1.0f / sqrtf(wave_sum((o0 * o0 + o1 * o1) + (o2 * o2 + o3 * o3)) * (1.0f / 256.0f) + EPS);
                *(u32x2*)(C.X3 + (size_t)m * D + 4 * lane + 256 * j) = (u32x2){pk2(o0 * rstd * wn[0] * siluf(bf_lo(gw2.x)), o1 * rstd * wn[1] * siluf(bf_hi(gw2.x))), pk2(o2 * rstd * wn[2] * siluf(bf_lo(gw2.y)), o3 * rstd * wn[3] * siluf(bf_hi(gw2.y)))}; } }
    }
}
template <int MODE> __device__ __forceinline__ void ew_rows(const Ctx& C, int tid) {
    const int wave = tid >> 6, lane = tid & 63, gw = blockIdx.x * 8 + wave, NGW = gridDim.x * 8;
    const float* wsc = MODE == 0 ? C.w_post : MODE == 1 ? C.w_fpost : C.w_ppost;
    const bf16* baseb = MODE == 1 ? C.HB : C.X1;
    f32x4 wv[4], wf[4];
#pragma unroll
    for (int j = 0; j < 4; ++j) { wv[j] = *(const f32x4*)(wsc + 4 * lane + 256 * j); wf[j] = MODE == 0 ? *(const f32x4*)(C.w_fpre + 4 * lane + 256 * j) : (f32x4){1.f, 1.f, 1.f, 1.f}; }
    const float* PARTS = C.PART + (WS_PARTS - WS_PART) / 4;
    float pA[2], pB[2]; u32x2 svA[2][4], svB[2][4], bbA[2][4], bbB[2][4]; f32x4 bvA[2][4], bvB[2][4];
#define EW_LOAD(X, g) do { _Pragma("unroll") for (int r = 0; r < 2; ++r) { const int m_ = gwx + NGW * (2 * (g) + r), m = m_ < MTOK ? m_ : MTOK - 1; \
            const float* pp = m >= MPROMPT ? PARTS + (size_t)lane * NSAMP + (m - MPROMPT) : C.PART + (size_t)(lane & 15) * MP + m; \
            const float pv = *pp; p##X[r] = (m < MPROMPT && lane >= 16) ? 0.f : pv; \
            const float* bp = m < MPROMPT ? C.xp + (size_t)m * D : C.xs + (size_t)(m - MPROMPT) * D; \
            _Pragma("unroll") for (int j = 0; j < 4; ++j) { const int c = 4 * lane + 256 * j; sv##X[r][j] = __builtin_nontemporal_load((const u32x2*)(C.X2 + (size_t)m * D + c)); \
                if (MODE == 0) bv##X[r][j] = __builtin_nontemporal_load((const f32x4*)(bp + c)); else bb##X[r][j] = __builtin_nontemporal_load((const u32x2*)(baseb + (size_t)m * D + c)); } } } while (0)
#define EW_COMP(X, g) do { _Pragma("unroll") for (int r = 0; r < 2; ++r) { const int m = gwx + NGW * (2 * (g) + r); \
            const float rs = 1.0f / sqrtf(wave_sum(p##X[r]) * (1.0f / D) + EPS); f32x4 hv[4]; float s = 0.f; \
            _Pragma("unroll") for (int j = 0; j < 4; ++j) { const u32x2 w = sv##X[r][j]; const f32x4 t = (f32x4){bf_lo(w.x), bf_hi(w.x), bf_lo(w.y), bf_hi(w.y)}; \
                f32x4 bs; if (MODE == 0) bs = bv##X[r][j]; else { const u32x2 bw = bb##X[r][j]; bs = (f32x4){bf_lo(bw.x), bf_hi(bw.x), bf_lo(bw.y), bf_hi(bw.y)}; } \
                hv[j] = bs + t * rs * wv[j]; s += (hv[j][0] * hv[j][0] + hv[j][1] * hv[j][1]) + (hv[j][2] * hv[j][2] + hv[j][3] * hv[j][3]); } \
            float rstd = 1.0f; if (MODE == 0) rstd = 1.0f / sqrtf(wave_sum(s) * (1.0f / D) + EPS); \
            if (m < MTOK) { _Pragma("unroll") for (int j = 0; j < 4; ++j) { const int c = 4 * lane + 256 * j; \
                if (MODE == 2) __builtin_nontemporal_store(hv[j], (f32x4*)(C.out + OUT_Y + (size_t)m * D + c)); \
                else { if (MODE == 0) __builtin_nontemporal_store((u32x2){pk2(hv[j][0], hv[j][1]), pk2(hv[j][2], hv[j][3])}, (u32x2*)(C.HB + (size_t)m * D + c)); \
                    const f32x4 o = hv[j] * rstd * wf[j]; *(u32x2*)(C.X1 + (size_t)m * D + c) = (u32x2){pk2(o[0], o[1]), pk2(o[2], o[3])}; } } } } } while (0)
    for (int gwx = gw; gwx < MTOK; gwx += 10 * NGW) {
    EW_LOAD(A, 0); EW_LOAD(B, 1); EW_COMP(A, 0); EW_LOAD(A, 2); EW_COMP(B, 1); EW_LOAD(B, 3); EW_COMP(A, 2); EW_LOAD(A, 4); EW_COMP(B, 3); EW_COMP(A, 4);
    }
#undef EW_LOAD
#undef EW_COMP
}

#define XB_TMO      128
#define XB_XCNT(j)  (256  + 64 * (j))
#define XB_XSUB(j)  (1280 + 64 * (j))
#define XB_XGEN(j)  (2304 + 64 * (j))
#define XB_TOP      3328
#define XB_TOPGEN   3392
#define XCD_BAR_WORDS 3456
#define XB_SPIN_CAP (1u << 18)

__device__ __forceinline__ unsigned xb_ld(unsigned* p)              { return __hip_atomic_load(p, __ATOMIC_RELAXED, __HIP_MEMORY_SCOPE_AGENT); }
__device__ __forceinline__ unsigned xb_add(unsigned* p, unsigned v) { return __hip_atomic_fetch_add(p, v, __ATOMIC_RELAXED, __HIP_MEMORY_SCOPE_AGENT); }
__device__ __forceinline__ unsigned xb_xcc_id() { return (unsigned)__builtin_amdgcn_s_getreg((3 << 11) | 20) & 0xFu; }
#define XB_SPIN(cond, bar) do { unsigned _sp = 0; while (cond) { __builtin_amdgcn_s_sleep(1); \
    if ((++_sp & 255u) == 0u) { if (xb_ld(&(bar)[XB_TMO])) break; if (_sp > XB_SPIN_CAP) { atomicAdd(&(bar)[XB_TMO], 1u); break; } } } } while (0)

struct XcdBarrier {
    unsigned* bar; unsigned x;
    volatile LAS unsigned* st;
};

__device__ __forceinline__ XcdBarrier xcd_barrier_post(unsigned* bar, volatile LAS unsigned* st) {
    XcdBarrier b; b.bar = bar; b.x = xb_xcc_id(); b.st = st;
    if (threadIdx.x == 0) (void)xb_add(&bar[XB_XCNT(b.x)], 1u);
    return b;
}
__device__ __forceinline__ void xcd_barrier_complete(unsigned* bar, unsigned x, unsigned& nloc, unsigned& nx) {
    const unsigned G = gridDim.x * gridDim.y * gridDim.z;
    unsigned sum, cnt, mine, sp = 0u;
    for (;;) {
        sum = 0u; cnt = 0u; mine = 0u;
#pragma unroll
        for (unsigned j = 0; j < 16; ++j) { const unsigned c = xb_ld(&bar[XB_XCNT(j)]); sum += c; cnt += (c > 0u) ? 1u : 0u; mine = (j == x) ? c : mine; }
        if (sum == G) break;
        __builtin_amdgcn_s_sleep(1);
        if ((++sp & 255u) == 0u) { if (xb_ld(&bar[XB_TMO])) break; if (sp > XB_SPIN_CAP) { atomicAdd(&bar[XB_TMO], 1u); break; } }
    }
    nloc = mine > 0u ? mine : 1u; nx = cnt > 0u ? cnt : 1u;
}

__device__ __forceinline__ void xcd_barrier(const XcdBarrier& b) {
    asm volatile("s_waitcnt vmcnt(0)" ::: "memory");
    __syncthreads();
    if (threadIdx.x == 0) {
        unsigned* bar = b.bar;
        __builtin_amdgcn_s_waitcnt(0);
        unsigned nloc = b.st[0], nx = b.st[1];
        if (nloc == 0u) { xcd_barrier_complete(bar, b.x, nloc, nx); b.st[0] = nloc; b.st[1] = nx; }
        const unsigned old = xb_add(&bar[XB_XSUB(b.x)], 1u);
        const unsigned gen = old / nloc;
        if (old + 1u == (gen + 1u) * nloc) {
            __builtin_amdgcn_fence(__ATOMIC_RELEASE, "agent");
            asm volatile("s_waitcnt vmcnt(0)" ::: "memory");
            const unsigned og = xb_add(&bar[XB_TOP], 1u);
            const unsigned tg = og / nx;
            if (og + 1u == (tg + 1u) * nx) xb_add(&bar[XB_TOPGEN], 1u);
            else XB_SPIN(xb_ld(&bar[XB_TOPGEN]) == tg, bar);
            __builtin_amdgcn_fence(__ATOMIC_ACQUIRE, "agent");
            xb_add(&bar[XB_XGEN(b.x)], 1u);
            asm volatile("s_waitcnt vmcnt(0)" ::: "memory");
        } else {
            XB_SPIN(xb_ld(&bar[XB_XGEN(b.x)]) == gen, bar);
            __builtin_amdgcn_fence(__ATOMIC_ACQUIRE, "agent");
            asm volatile("s_waitcnt vmcnt(0)" ::: "memory");
        }
    }
    __syncthreads();
}


constexpr int NPHASE = 13;
__global__ void __launch_bounds__(512, 2) fwd_mega(Args a) {
    extern __shared__ __attribute__((aligned(16))) unsigned char lds_raw[];
    LAS unsigned char* lds = (LAS unsigned char*)lds_raw;
    const int tid = threadIdx.x, G = gridDim.x, bx = blockIdx.x;
    Ctx C;
    C.xp = a.in[0]; C.xs = a.in[1]; C.st_conv = a.in[2]; C.st_gla = a.in[3]; C.pp = a.in[4]; C.ps = a.in[5]; C.w_pre = a.in[6]; C.w_in = a.in[7]; C.w_conv = a.in[8]; C.w_a = a.in[9];
    C.w_gk = a.in[10]; C.b_gk = a.in[11]; C.w_gn = a.in[12]; C.w_b = a.in[13]; C.w_o = a.in[14]; C.w_post = a.in[15]; C.w_fpre = a.in[16]; C.w_fg = a.in[17]; C.w_fu = a.in[18]; C.w_fd = a.in[19];
    C.w_fpost = a.in[20]; C.w_pp = a.in[21]; C.w_pg = a.in[22]; C.w_ppost = a.in[23]; C.out = a.out;
    unsigned char* ws = a.ws;
    C.WIN = (bf16*)(ws + WS_WIN); C.WA = (bf16*)(ws + WS_WA); C.WB = (bf16*)(ws + WS_WB); C.WO = (bf16*)(ws + WS_WO); C.WPG = (bf16*)(ws + WS_WPG); C.WPP = (bf16*)(ws + WS_WPP);
    C.WGU = (bf16*)(ws + WS_WGU); C.WD = (bf16*)(ws + WS_WD); C.PB = (bf16*)(ws + WS_PB); C.X1 = (bf16*)(ws + WS_X1); C.X2 = (bf16*)(ws + WS_X2); C.X3 = (bf16*)(ws + WS_X3); C.X4 = (bf16*)(ws + WS_X4);
    C.Z = (bf16*)(ws + WS_Z); C.HID = (bf16*)(ws + WS_HID); C.KHT = (bf16*)(ws + WS_KHT); C.SC = (bf16*)(ws + WS_SC);
    C.GKLR = (float*)(ws + WS_GKLR); C.PART = (float*)(ws + WS_PART); C.DBUF = (float*)(ws + WS_DBUF); C.HB = (bf16*)(ws + WS_H); C.QT = (bf16*)(ws + WS_QT); C.WGK = (bf16*)(ws + WS_WGK);
    const int lo = a.ph_lo, hi = a.ph_hi;
#define IN(k) (lo <= (k) && (k) < hi)
    if (tid < 4) ((LAS unsigned*)(lds + LDS_BARST))[tid] = 0u;
    __syncthreads();
    const XcdBarrier bar = xcd_barrier_post((unsigned*)(ws + WS_CTL), (volatile LAS unsigned*)(lds + LDS_BARST));
    if (lo == 0x7fffffff) cg::this_grid().sync();
#define SEAM(k) do { if (IN(k) && IN((k) + 1)) xcd_barrier(bar); } while (0)
#define GEMM(EPI, Aptr, Bptr, Mv, Nv, Kv, Eobj) do { pg8::Gemm g{(const pg8::bf16_t*)(Aptr), (const pg8::bf16_t*)(Bptr), Mv, Nv, Kv}; pg8::StaticOrder S; S.init(Mv, Nv, G, bx); \
        pg8::gemm_phase<EPI, pg8::StaticOrder, true, true>(lds, g, S, Eobj); } while (0)

    if (IN(0)) for (int r_ = 0; r_ < REP[0]; ++r_) { p0_prologue(C, lds, tid); } SEAM(0);
    const size_t SR = (size_t)MPROMPT;
    float* PARTS = (float*)(ws + WS_PARTS);
    if (IN(1)) { const bool late_first = (bx >> 3) & 1;
        if (late_first) { int t_ = tid; asm volatile("" : "+v"(t_)); p0_late(C, lds, t_); __syncthreads(); }
        { EpiStore E{C.Z, NZ}; GEMM(EpiStore, C.X1, C.WIN, MPROMPT, NZ, D, E); }
        { MiniStore E{C.Z, NZ}; mini_gemm<false>(C.X1, MPROMPT, 1, C.WIN, D, NZ / 16, 0, E, lds, tid); }
        { MiniF32 E{C.GKLR, 16}; mini_gemm<false>(C.X1, 0, MTOK / 128, C.WGK, D, 1, 64, E, lds, tid); }
        if (!late_first) { int t_ = tid; asm volatile("" : "+v"(t_)); p0_late(C, lds, t_); } } SEAM(1);
    if (IN(2)) for (int r_ = 0; r_ < REP[2]; ++r_) {
        if ((bx >> 3) & 1) { conv_phase(C, tid); for (int it = bx; it < NSAMP * 4; it += G) gla_sample_item(C, it, lds, tid); }
        { PrepRegs Rn; if (bx < 1024) prep_load(C, bx, tid, Rn);
          for (int it = bx; it < 1024; it += G) { const PrepRegs Rc = Rn; if (it + G < 1024) prep_load(C, it + G, tid, Rn); gla_prep_item(C, it, lds, tid, Rc); } }
        if (!((bx >> 3) & 1)) { for (int it = bx; it < NSAMP * 4; it += G) gla_sample_item(C, it, lds, tid); conv_phase(C, tid); }
    } SEAM(2);
    if (IN(3)) for (int r_ = 0; r_ < REP[3]; ++r_) { for (int it = bx; it < 256; it += G) gla_scan_item(C, it, lds, tid); } SEAM(3);
    if (IN(4)) { const bool gemm_first = !((bx >> 3) & 1);
        if (!gemm_first) { int t_ = tid; asm volatile("" : "+v"(t_)); p4_onorm(C, t_); }
        { EpiGate<false> E{C.Z + ZGA, nullptr, C.X1}; GEMM(EpiGate<false>, C.X2, C.WA, MPROMPT, D, D, E); }
        if (gemm_first) { int t_ = tid; asm volatile("" : "+v"(t_)); p4_onorm(C, t_); } } SEAM(4);
    if (IN(5)) for (int r_ = 0; r_ < REP[5]; ++r_) {
        { EpiGate<true> E{C.Z + ZGB, C.X1, C.X1}; GEMM(EpiGate<true>, C.X3, C.WB, MPROMPT, D, D, E); }
        { MiniGate<false> E{C.Z + ZGA, nullptr, C.X1}; mini_gemm<false, 2>(C.X2, MPROMPT, 1, C.WA, D, D / 16, 0, E, lds, tid); }
        { MiniGate<true> E{C.Z + ZGB, C.X1, C.X1}; mini_gemm<false, 2>(C.X3, MPROMPT, 1, C.WB, D, D / 16, 0, E, lds, tid); }
    } SEAM(5);
    if (IN(6)) for (int r_ = 0; r_ < REP[6]; ++r_) { { EpiSq<false> E{C.X2, nullptr, C.PART}; GEMM(EpiSq<false>, C.X1, C.WO, MPROMPT, D, D, E); }
        { MiniSq<false> E{C.X2, nullptr, PARTS}; mini_gemm<false, 2>(C.X1, MPROMPT, 1, C.WO, D, D / 16, 0, E, lds, tid); } } SEAM(6);
    if (IN(7)) for (int r_ = 0; r_ < REP[7]; ++r_) { ew_rows<0>(C, tid); } SEAM(7);
    if (IN(8)) for (int r_ = 0; r_ < REP[8]; ++r_) { { EpiSwiGLU E{C.HID}; GEMM(EpiSwiGLU, C.X1, C.WGU, MPROMPT, 2 * FF, D, E); }
        { MiniSwiGLU E{C.HID}; mini_gemm<true>(C.X1, MPROMPT, 1, C.WGU, D, FF / 16, G / 2, E, lds, tid); }
        { EpiStore E{C.X3, D}; pg8::Gemm g{(const pg8::bf16_t*)C.PB, (const pg8::bf16_t*)C.WPP, MPROMPT, D, PLE}; pg8::StaticOrder S;
          const int hG = G / 2; S.init(MPROMPT, D, G >= 2 ? hG : 1, G >= 2 ? (bx >= hG ? bx - hG : 0x3fffffff) : 0);
          pg8::gemm_phase<EpiStore, pg8::StaticOrder, true, true>(lds, g, S, E); } } SEAM(8);
    if (IN(9)) for (int r_ = 0; r_ < REP[9]; ++r_) { { EpiSq<false> E{C.X2, nullptr, C.PART}; GEMM(EpiSq<false>, C.HID, C.WD, MPROMPT, D, FF, E); }
        { MiniSq<false> E{C.X2, nullptr, PARTS}; mini_gemm<false, 2>(C.HID, MPROMPT, 1, C.WD, FF, D / 16, 0, E, lds, tid); } } SEAM(9);
    if (IN(10)) for (int r_ = 0; r_ < REP[10]; ++r_) { ew_rows<1>(C, tid); } SEAM(10);
    if (IN(11)) for (int r_ = 0; r_ < REP[11]; ++r_) {
        { EpiSq<true> E{C.X2, C.X3, C.PART}; GEMM(EpiSq<true>, C.X1, C.WPG, MPROMPT, D, D, E); }
        { MiniStore E{C.X3, D}; mini_gemm<false, 2>(C.PB, MPROMPT, 1, C.WPP, PLE, D / 16, 0, E, lds, tid); }
        { MiniSq<true> E{C.X2, C.X3, PARTS}; mini_gemm<false, 2>(C.X1, MPROMPT, 1, C.WPG, D, D / 16, 0, E, lds, tid); }
    } SEAM(11);
    if (IN(12)) for (int r_ = 0; r_ < REP[12]; ++r_) { ew_rows<2>(C, tid); }
}

extern "C" void kernel_launch(void* const* d_in, const int* in_sizes, int n_in, void* d_out, int out_size, void* d_ws, size_t ws_size, hipStream_t stream) {
    static int grid = 0;
    if (grid == 0) {
        int dev = 0, cus = 0, per_cu = 0;
        hipGetDevice(&dev); hipDeviceGetAttribute(&cus, hipDeviceAttributeMultiprocessorCount, dev);
        if (hipFuncSetAttribute((const void*)fwd_mega, hipFuncAttributeMaxDynamicSharedMemorySize, LDS_BYTES) != hipSuccess) { fprintf(stderr, "hipFuncSetAttribute failed\n"); }
        if (hipOccupancyMaxActiveBlocksPerMultiprocessor(&per_cu, (const void*)fwd_mega, 512, LDS_BYTES) != hipSuccess || per_cu < 1) { fprintf(stderr, "occupancy query: %d\n", per_cu); per_cu = 1; }
        (void)hipGetLastError();
        grid = cus * (per_cu > 1 ? 1 : per_cu);
        if (ws_size < WS_END) fprintf(stderr, "workspace too small: %zu < %zu\n", ws_size, (size_t)WS_END);
    }
    (void)hipMemsetAsync((char*)d_ws + WS_CTL, 0, CTL_BYTES, stream);
    Args a{};
    for (int i = 0; i < 24; ++i) a.in[i] = (const float*)d_in[i];
    a.out = (float*)d_out; a.ws = (unsigned char*)d_ws;
#if MK_PER_PHASE
    { const int plist[] = {PHASE_LIST}; for (int p : plist) { a.ph_lo = p; a.ph_hi = p + 1; hipLaunchKernelGGL(fwd_mega, dim3(grid), dim3(512), LDS_BYTES, stream, a); } }
#else
    a.ph_lo = 0; a.ph_hi = NPHASE;
    void* args[] = {&a};
    hipError_t e = hipLaunchCooperativeKernel((const void*)fwd_mega, dim3(grid), dim3(512), args, LDS_BYTES, stream);
    if (e != hipSuccess) fprintf(stderr, "cooperative launch failed: %s (grid %d)\n", hipGetErrorString(e), grid);
#endif
}
```
